# Optimizing an MI355X kernel written in HIP

```python
import jax, jax.numpy as jnp
from jax import lax
import numpy as np

D_MODEL = 2048
BATCH = 4
SEQ = 2048
DEPTH = 1

HEAD_DIM = 128
N_HEADS_MOBA = 8
N_HEADS_SB = 8
D_MOBA = N_HEADS_MOBA * HEAD_DIM
D_SB = N_HEADS_SB * HEAD_DIM
D_MIX = D_MOBA + D_SB
D_QKV = 3 * D_MIX
D_FF = 4 * D_MODEL
MOBA_BLOCK = 256
MOBA_TOPK = 3
MOBA_Q_CHUNK = 16
SB_Q_BLOCK = 128
ROPE_THETA = 500000.0
ROPE_DIMS = HEAD_DIM // 4
EPS = 1e-6
NEG = -1e30

kernel_name = "hymba_moba_stickbreaking_sqrelu_block"


def rmsnorm(x, g):
    xf = x.astype(jnp.float32)
    y = xf * lax.rsqrt(jnp.mean(xf * xf, axis=-1, keepdims=True) + EPS)
    return (y * g.astype(jnp.float32)).astype(x.dtype)


def partial_rope(t, pos):
    half = ROPE_DIMS // 2
    inv_freq = ROPE_THETA ** (-jnp.arange(half, dtype=jnp.float32) / half)
    ang = pos.astype(jnp.float32)[:, None] * inv_freq[None, :]
    cos, sin = jnp.cos(ang), jnp.sin(ang)
    tr = t[..., :ROPE_DIMS].astype(jnp.float32)
    t1, t2 = tr[..., :half], tr[..., half:]
    rot = jnp.concatenate([t1 * cos - t2 * sin, t1 * sin + t2 * cos], axis=-1)
    return jnp.concatenate([rot.astype(t.dtype), t[..., ROPE_DIMS:]], axis=-1)


def moba_attention(q, k, v):
    B, H, S, Dh = q.shape
    n_blk = -(-S // MOBA_BLOCK)
    pad = n_blk * MOBA_BLOCK - S
    kb = jnp.pad(k, ((0, 0), (0, 0), (0, pad), (0, 0))).reshape(B, H, n_blk, MOBA_BLOCK, Dh)
    vb = jnp.pad(v, ((0, 0), (0, 0), (0, pad), (0, 0))).reshape(B, H, n_blk, MOBA_BLOCK, Dh)
    topk = min(MOBA_TOPK, n_blk)
    scale = Dh ** -0.5

    k_mean = jnp.mean(kb.astype(jnp.float32), axis=3)
    gate = jnp.einsum('bhsd,bhnd->bhsn', q.astype(jnp.float32), k_mean)
    q_blk = jnp.arange(S) // MOBA_BLOCK
    past = jnp.arange(n_blk)[None, :] < q_blk[:, None]
    gate = jnp.where(past, gate, NEG)
    _, sel = lax.top_k(gate, topk)

    n_chunk = S // MOBA_Q_CHUNK

    def to_chunks(a):
        return jnp.moveaxis(a.reshape(B, H, n_chunk, MOBA_Q_CHUNK, *a.shape[3:]), 2, 0)

    b_idx = jnp.arange(B)[:, None, None, None]
    h_idx = jnp.arange(H)[None, :, None, None]
    key_off = jnp.arange(MOBA_BLOCK)

    def chunk_fn(args):
        c, qc, selc = args
        q_pos = c * MOBA_Q_CHUNK + jnp.arange(MOBA_Q_CHUNK)
        blk = (c * MOBA_Q_CHUNK) // MOBA_BLOCK
        kg = kb[b_idx, h_idx, selc]
        vg = vb[b_idx, h_idx, selc]
        s_past = jnp.einsum('bhcd,bhcrkd->bhcrk', qc, kg,
                            preferred_element_type=jnp.float32) * scale
        slot_valid = jnp.arange(topk) < blk
        s_past = jnp.where(slot_valid[:, None], s_past, NEG)
        s_past = s_past.reshape(B, H, MOBA_Q_CHUNK, topk * MOBA_BLOCK)
        k_own = lax.dynamic_index_in_dim(kb, blk, axis=2, keepdims=False)
        v_own = lax.dynamic_index_in_dim(vb, blk, axis=2, keepdims=False)
        s_own = jnp.einsum('bhcd,bhkd->bhck', qc, k_own,
                           preferred_element_type=jnp.float32) * scale
        own_pos = blk * MOBA_BLOCK + key_off
        s_own = jnp.where(own_pos[None, :] <= q_pos[:, None], s_own, NEG)
        p = jax.nn.softmax(jnp.concatenate([s_past, s_own], axis=-1), axis=-1)
        p_past = p[..., :topk * MOBA_BLOCK].astype(v.dtype)
        p_own = p[..., topk * MOBA_BLOCK:].astype(v.dtype)
        o = jnp.einsum('bhck,bhckd->bhcd', p_past,
                       vg.reshape(B, H, MOBA_Q_CHUNK, topk * MOBA_BLOCK, Dh),
                       preferred_element_type=jnp.float32)
        o = o + jnp.einsum('bhck,bhkd->bhcd', p_own, v_own, preferred_element_type=jnp.float32)
        return o.astype(q.dtype)

    out = lax.map(chunk_fn, (jnp.arange(n_chunk), to_chunks(q), to_chunks(sel)))
    return jnp.moveaxis(out, 0, 2).reshape(B, H, S, Dh)


def stick_breaking_attention(q, k, v):
    B, H, S, Dh = q.shape
    n_qblk = S // SB_Q_BLOCK
    scale = Dh ** -0.5
    key_pos = jnp.arange(S)
    q_blocks = jnp.moveaxis(q.reshape(B, H, n_qblk, SB_Q_BLOCK, Dh), 2, 0)

    def block_fn(args):
        i, qb = args
        q_pos = i * SB_Q_BLOCK + jnp.arange(SB_Q_BLOCK)
        z = jnp.einsum('bhqd,bhkd->bhqk', qb, k, preferred_element_type=jnp.float32) * scale
        causal = key_pos[None, :] < q_pos[:, None]
        log_beta = jax.nn.log_sigmoid(z)
        log_1m_beta = jnp.where(causal, jax.nn.log_sigmoid(-z), 0.0)
        log_stay = lax.cumsum(log_1m_beta, axis=3, reverse=True) - log_1m_beta
        a = jnp.where(causal, jnp.exp(log_beta + log_stay), 0.0)
        o = jnp.einsum('bhqk,bhkd->bhqd', a.astype(v.dtype), v, preferred_element_type=jnp.float32)
        return o.astype(q.dtype)

    out = lax.map(block_fn, (jnp.arange(n_qblk), q_blocks))
    return jnp.moveaxis(out, 0, 2).reshape(B, H, S, Dh)


def setup_inputs(seed: int = 0) -> dict:
    key = jax.random.key(seed)
    ks = jax.random.split(key, 12)
    f32 = jnp.float32
    x = jax.random.normal(ks[0], (BATCH, SEQ, D_MODEL), f32)
    mix_norm_g = 1.0 + 0.02 * jax.random.normal(ks[1], (DEPTH, D_MODEL), f32)
    w_in = jax.random.normal(ks[2], (DEPTH, D_MODEL, D_QKV), f32) * D_MODEL ** -0.5
    moba_out_g = 1.0 + 0.02 * jax.random.normal(ks[3], (DEPTH, D_MOBA), f32)
    sb_out_g = 1.0 + 0.02 * jax.random.normal(ks[4], (DEPTH, D_SB), f32)
    w_out = jax.random.normal(ks[5], (DEPTH, D_MIX, D_MODEL), f32) * D_MIX ** -0.5
    mlp_norm_g = 1.0 + 0.02 * jax.random.normal(ks[6], (DEPTH, D_MODEL), f32)
    w_up = jax.random.normal(ks[7], (DEPTH, D_MODEL, D_FF), f32) * D_MODEL ** -0.5
    w_down = jax.random.normal(ks[8], (DEPTH, D_FF, D_MODEL), f32) * D_FF ** -0.5
    final_norm_g = 1.0 + 0.02 * jax.random.normal(ks[9], (D_MODEL,), f32)
    return {"x": x, "mix_norm_g": mix_norm_g, "w_in": w_in, "moba_out_g": moba_out_g,
            "sb_out_g": sb_out_g, "w_out": w_out, "mlp_norm_g": mlp_norm_g,
            "w_up": w_up, "w_down": w_down, "final_norm_g": final_norm_g}


def reference(x, mix_norm_g, w_in, moba_out_g, sb_out_g, w_out, mlp_norm_g, w_up, w_down,
              final_norm_g):
    B, S, _ = x.shape
    pos = jnp.arange(S)

    def heads(t, n_heads):
        return t.reshape(B, S, n_heads, HEAD_DIM).transpose(0, 2, 1, 3)

    def merge(t):
        return t.transpose(0, 2, 1, 3).reshape(B, S, -1)

    for l in range(DEPTH):
        h = rmsnorm(x, mix_norm_g[l])
        qkv = jnp.einsum('bsd,de->bse', h, w_in[l])
        q_a, k_a, v_a, q_b, k_b, v_b = jnp.split(
            qkv, [D_MOBA, 2 * D_MOBA, 3 * D_MOBA, 3 * D_MOBA + D_SB, 3 * D_MOBA + 2 * D_SB], axis=-1)
        q_a = partial_rope(heads(q_a, N_HEADS_MOBA), pos)
        k_a = partial_rope(heads(k_a, N_HEADS_MOBA), pos)
        o_a = moba_attention(q_a, k_a, heads(v_a, N_HEADS_MOBA))
        o_b = stick_breaking_attention(heads(q_b, N_HEADS_SB), heads(k_b, N_HEADS_SB),
                                       heads(v_b, N_HEADS_SB))
        o = jnp.concatenate([rmsnorm(merge(o_a), moba_out_g[l]),
                             rmsnorm(merge(o_b), sb_out_g[l])], axis=-1)
        x = x + jnp.einsum('bse,ed->bsd', o, w_out[l])
        h = rmsnorm(x, mlp_norm_g[l])
        u = jnp.einsum('bsd,df->bsf', h, w_up[l])
        x = x + jnp.einsum('bsf,fd->bsd', jnp.square(jax.nn.relu(u)), w_down[l])
    return rmsnorm(x, final_norm_g)
```

```cpp
#define MK_MODE 0
#define NAIVE_MOBA 0
#define NAIVE_SB 0
#include <hip/hip_runtime.h>
#include <cstdio>
#include <cstdint>
namespace pg8 {
#define PG8_LAS __attribute__((address_space(3)))
typedef unsigned short bf16_t;
typedef short bf16x8 __attribute__((ext_vector_type(8)));
typedef float f32x4 __attribute__((ext_vector_type(4)));
typedef unsigned u32x4 __attribute__((ext_vector_type(4)));
constexpr int BM = 256, BK = 64, HALF = 128, HTB = HALF * BK * 2  , STAGE_BYTES = 8 * HTB, NXCD = 8, WGM = 8;

__host__ __device__ __forceinline__ int lds_byte(int r, int c) { const int st = (r >> 4) * 2 + (c >> 5), rr = r & 15, cc = c & 31, ob = rr * 64 + cc * 2; return st * 1024 + (ob ^ (((ob >> 9) & 1) << 5)); }
__host__ __device__ __forceinline__ void stage_rc(int b, int& R, int& C) { const int st = b / 1024, sb = b % 1024, swz = sb ^ (((sb >> 9) & 1) << 5); R = (st >> 1) * 16 + swz / 64; C = (st & 1) * 32 + (swz % 64) / 2; }
__host__ __device__ __forceinline__ int perm32(int rho) { const int n = rho >> 4, i = rho & 15; return 8 * (i >> 2) + 4 * n + (i & 3); }

struct Unit { int pm, pn; };
struct Gemm { const bf16_t* A; const bf16_t* Bt; int M, N, K; };

struct StaticOrder {
    int nM, nN, nwg, G, c;
    __host__ __device__ void init(int M, int N, int G_, int c_) { nM = M / BM; nN = N / BM; nwg = nM * nN; G = G_; c = c_; }
    __host__ __device__ bool next(int i, Unit& u) const {
        const long L = (long)i * G + c; if (L >= nwg) return false;
        int wgid = (int)L; { const int q = nwg / NXCD, r = nwg % NXCD, xcd = wgid % NXCD, off = wgid / NXCD; wgid = (xcd < r ? xcd * (q + 1) : r * (q + 1) + (xcd - r) * q) + off; }
        const int nig = WGM * nN, gid = wgid / nig, fm = gid * WGM, gsz = (nM - fm) < WGM ? (nM - fm) : WGM;
        u.pm = fm + ((wgid % nig) % gsz); u.pn = (wgid % nig) / gsz; return true;
    }
    __device__ __forceinline__ void a_ready(const Unit&) const {}
    __device__ __forceinline__ void done(const Unit&) const {}
};


__device__ __forceinline__ unsigned cvt_pk_bf16(float lo, float hi) { unsigned r; asm volatile("v_cvt_pk_bf16_f32 %0, %1, %2" : "=v"(r) : "v"(lo), "v"(hi)); return r; }
__device__ __forceinline__ float xchg32(float v, bool upper) {
    auto r = __builtin_amdgcn_permlane32_swap(__float_as_uint(v), __float_as_uint(v), false, false);
    return __uint_as_float(upper ? r[0] : r[1]);
}
constexpr int P_M = 8192, P_SEQ = 2048, P_NH = 8, P_HD = 128, P_DG = 1024, P_DM = 2048, P_DFF = 8192;
constexpr float P_EPS = 1e-6f;
constexpr float P_C2 = 0.08838834764831845f * 1.4426950408889634f;

struct EpiQKV {
    static constexpr bool PERM = true, AFTER_DRAIN = false, HAS_MID = false;
    bf16_t* QKV; const float* r0; const float* rope; float* kmean;
    __device__ __forceinline__ void mid(f32x4 (&)[2][2][4][2], int, int) const {}
    __device__ __forceinline__ void operator()(const f32x4 (&acc)[2][2][4][2], const Unit& u, int wr, int wc, int fr, int fq) const {
        const int t = u.pn >> 2, hb = (u.pn & 3) * 2;
        const bool isq = (t == 0) || (t == 3), dorope = (t <= 1) && (wc == 0), iska = (t == 1);
        const float qs = isq ? P_C2 : 1.f;
        const int b = u.pm >> 3, blk = u.pm & 7;
        bf16_t* base = QKV + (size_t)t * ((size_t)P_M * P_DG) + ((size_t)(b * P_NH + hb) * P_SEQ) * P_HD + wc * 32 + fq * 8;
        const float sgn = (fq < 2) ? -1.f : 1.f; const int j0 = 8 * (fq & 1); const bool upper = fq >= 2;
        f32x4 ks[2][2];
#pragma unroll
        for (int bj = 0; bj < 2; ++bj)
#pragma unroll
            for (int n = 0; n < 2; ++n) ks[bj][n] = (f32x4){0.f, 0.f, 0.f, 0.f};
#pragma unroll
        for (int ai = 0; ai < 2; ++ai)
#pragma unroll
            for (int m = 0; m < 4; ++m) {
                const int rt = ai * HALF + wr * 64 + m * 16 + fr, s = blk * 256 + rt;
                const float rs = r0[u.pm * BM + rt] * qs;
                f32x4 c4[2], s4[2];
                if (dorope) { const float* rp = rope + s * 32 + j0; c4[0] = *(const f32x4*)rp; c4[1] = *(const f32x4*)(rp + 4); s4[0] = *(const f32x4*)(rp + 16) * sgn; s4[1] = *(const f32x4*)(rp + 20) * sgn; }
#pragma unroll
                for (int bj = 0; bj < 2; ++bj) {
                    f32x4 v[2] = {acc[ai][bj][m][0] * rs, acc[ai][bj][m][1] * rs};
                    if (dorope) {
#pragma unroll
                        for (int n = 0; n < 2; ++n)
#pragma unroll
                            for (int e = 0; e < 4; ++e) { const float o = xchg32(v[n][e], upper); v[n][e] = v[n][e] * c4[n][e] + o * s4[n][e]; }
                    }
                    if (iska) { ks[bj][0] += v[0]; ks[bj][1] += v[1]; }
                    u32x4 w; w.x = cvt_pk_bf16(v[0][0], v[0][1]); w.y = cvt_pk_bf16(v[0][2], v[0][3]); w.z = cvt_pk_bf16(v[1][0], v[1][1]); w.w = cvt_pk_bf16(v[1][2], v[1][3]);
                    *(u32x4*)(base + ((size_t)bj * P_SEQ + s) * P_HD) = w;
                }
            }
        if (iska) {
#pragma unroll
            for (int bj = 0; bj < 2; ++bj)
#pragma unroll
                for (int n = 0; n < 2; ++n)
#pragma unroll
                    for (int e = 0; e < 4; ++e) { float x = ks[bj][n][e]; x += __shfl_xor(x, 1); x += __shfl_xor(x, 2); x += __shfl_xor(x, 4); x += __shfl_xor(x, 8);
                        if (fr == 0) atomicAdd(kmean + ((size_t)((b * P_NH + hb + bj) * 8 + blk)) * P_HD + wc * 32 + fq * 8 + n * 4 + e, x * (1.0f / 256.0f)); }
        }
    }
};

struct EpiUp {
    static constexpr bool PERM = true, AFTER_DRAIN = false, HAS_MID = false;
    bf16_t* O; const float* ssq;
    __device__ __forceinline__ void mid(f32x4 (&)[2][2][4][2], int, int) const {}
    __device__ __forceinline__ void operator()(const f32x4 (&acc)[2][2][4][2], const Unit& u, int wr, int wc, int fr, int fq) const {
#pragma unroll
        for (int ai = 0; ai < 2; ++ai)
#pragma unroll
            for (int m = 0; m < 4; ++m) {
                const int row = u.pm * BM + ai * HALF + wr * 64 + m * 16 + fr;
                float sq = 0.f;
#pragma unroll
                for (int p = 0; p < 8; ++p) sq += ssq[(size_t)p * P_M + row];
                const float r = 1.0f / sqrtf(sq * (1.0f / P_DM) + P_EPS);
                bf16_t* rowp = O + (size_t)row * P_DFF + u.pn * BM + wc * 32 + fq * 8;
#pragma unroll
                for (int bj = 0; bj < 2; ++bj) {
                    f32x4 v0 = acc[ai][bj][m][0] * r, v1 = acc[ai][bj][m][1] * r;
#pragma unroll
                    for (int e = 0; e < 4; ++e) { const float a = fmaxf(v0[e], 0.f), c = fmaxf(v1[e], 0.f); v0[e] = a * a; v1[e] = c * c; }
                    u32x4 w; w.x = cvt_pk_bf16(v0[0], v0[1]); w.y = cvt_pk_bf16(v0[2], v0[3]); w.z = cvt_pk_bf16(v1[0], v1[1]); w.w = cvt_pk_bf16(v1[2], v1[3]);
                    *(u32x4*)(rowp + bj * HALF) = w;
                }
            }
    }
};

__device__ __forceinline__ void row_ssq_publish(const float (&ss)[2][4], const Unit& u, int wr, int wc, int fr, int fq, PG8_LAS float* P  , float* dst  ) {
#pragma unroll
    for (int ai = 0; ai < 2; ++ai)
#pragma unroll
        for (int m = 0; m < 4; ++m) { float s = ss[ai][m]; s += __shfl_xor(s, 16); s += __shfl_xor(s, 32);
            if (fq == 0) P[(ai * HALF + wr * 64 + m * 16 + fr) * 4 + wc] = s; }
    asm volatile("s_waitcnt lgkmcnt(0)" ::: "memory"); __builtin_amdgcn_s_barrier(); asm volatile("" ::: "memory");
    const int tid = threadIdx.x;
    if (tid < 256) { const float s = (P[tid * 4 + 0] + P[tid * 4 + 1]) + (P[tid * 4 + 2] + P[tid * 4 + 3]); dst[(size_t)u.pn * P_M + u.pm * BM + tid] = s; }
}

struct EpiOut {
    static constexpr bool PERM = false, AFTER_DRAIN = true, HAS_MID = true;
    const float* x; float* x1; bf16_t* x1b; float* ssq1; PG8_LAS const float* tab  ; PG8_LAS float* P;
    __device__ __forceinline__ void mid(f32x4 (&acc)[2][2][4][2], int wr, int fr) const {
#pragma unroll
        for (int ai = 0; ai < 2; ++ai)
#pragma unroll
            for (int m = 0; m < 4; ++m) { const float f = tab[(ai * HALF + wr * 64 + m * 16 + fr) * 2];
#pragma unroll
                for (int bj = 0; bj < 2; ++bj)
#pragma unroll
                    for (int n = 0; n < 2; ++n) acc[ai][bj][m][n] *= f; }
    }
    __device__ __forceinline__ void fused(f32x4 (&acc)[2][2][4][2], const Unit& u, int wr, int wc, int fr, int fq, PG8_LAS unsigned char*, int, int) const {
        typedef unsigned u32x2v __attribute__((ext_vector_type(2)));
        const int col0 = u.pn * BM + wc * 32 + 4 * fq; float ss[2][4];
#pragma unroll
        for (int ai = 0; ai < 2; ++ai)
#pragma unroll
            for (int m = 0; m < 4; ++m) { const int r = ai * HALF + wr * 64 + m * 16 + fr; const float rb = tab[r * 2 + 1]; const size_t off = (size_t)(u.pm * BM + r) * P_DM + col0; float s = 0.f;
#pragma unroll
                for (int bj = 0; bj < 2; ++bj)
#pragma unroll
                    for (int n = 0; n < 2; ++n) { const f32x4 xin = *(const f32x4*)(x + off + bj * HALF + n * 16); const f32x4 o = xin + acc[ai][bj][m][n] * rb;
                        *(f32x4*)(x1 + off + bj * HALF + n * 16) = o; u32x2v w; w.x = cvt_pk_bf16(o[0], o[1]); w.y = cvt_pk_bf16(o[2], o[3]); *(u32x2v*)(x1b + off + bj * HALF + n * 16) = w;
                        s += (o[0] * o[0] + o[1] * o[1]) + (o[2] * o[2] + o[3] * o[3]); }
                ss[ai][m] = s; }
        row_ssq_publish(ss, u, wr, wc, fr, fq, P, ssq1);
    }
};

struct EpiDown {
    static constexpr bool PERM = false, AFTER_DRAIN = true, HAS_MID = false;
    float* xio; float* ssq2; PG8_LAS float* P;
    __device__ __forceinline__ void mid(f32x4 (&)[2][2][4][2], int, int) const {}
    __device__ __forceinline__ void fused(f32x4 (&acc)[2][2][4][2], const Unit& u, int wr, int wc, int fr, int fq, PG8_LAS unsigned char*, int, int) const {
        const int col0 = u.pn * BM + wc * 32 + 4 * fq; float ss[2][4];
#pragma unroll
        for (int ai = 0; ai < 2; ++ai)
#pragma unroll
            for (int m = 0; m < 4; ++m) { const int r = ai * HALF + wr * 64 + m * 16 + fr; const size_t off = (size_t)(u.pm * BM + r) * P_DM + col0; float s = 0.f;
#pragma unroll
                for (int bj = 0; bj < 2; ++bj)
#pragma unroll
                    for (int n = 0; n < 2; ++n) { const f32x4 o = *(const f32x4*)(xio + off + bj * HALF + n * 16) + acc[ai][bj][m][n];
                        *(f32x4*)(xio + off + bj * HALF + n * 16) = o; s += (o[0] * o[0] + o[1] * o[1]) + (o[2] * o[2] + o[3] * o[3]); }
                ss[ai][m] = s; }
        row_ssq_publish(ss, u, wr, wc, fr, fq, P, ssq2);
    }
};

template <class Epi, class Sched, bool ALIGN_EPI = false, bool SP2 = false>
__device__ __forceinline__ void gemm_phase(PG8_LAS unsigned char* lds, const Gemm g, const Sched& S, const Epi& E) {
    int tid_ = threadIdx.x; asm volatile("" : "+v"(tid_));
    const int tid = tid_, wid = __builtin_amdgcn_readfirstlane(tid >> 6), lane = tid & 63, wr = wid >> 2, wc = wid & 3, fr = lane & 15, fq = lane >> 4;
    const int K = g.K, nt = K / BK;
    unsigned voffA[2], voffB[2];
#pragma unroll
    for (int i = 0; i < 2; ++i) { int R, C; stage_rc(tid * 16 + i * 8192, R, C); const int Rb = Epi::PERM ? ((R & ~31) + perm32(R & 31)) : R;
        voffA[i] = (unsigned)(R * K + C) * 2u; voffB[i] = (unsigned)(Rb * K + C) * 2u; }
    const size_t kstep = (size_t)(BK * 2);
    const size_t hstep = (size_t)HALF * K * 2;
    const size_t tstep = 2 * hstep;
    const unsigned ldsw = (unsigned)wid * 1024u;
    const int aoff = lds_byte(wr * 64 + fr, fq * 8), boff = lds_byte(wc * 32 + fr, fq * 8);
#define PG8_SA(b, h) (((b) * 2 + (h)) * HTB)
#define PG8_SB(b, h) ((4 + (b) * 2 + (h)) * HTB)
#define PG8_STAGE(bufoff, gbase, voff) do { _Pragma("unroll") for (int _i = 0; _i < 2; ++_i) \
        __builtin_amdgcn_global_load_lds((const unsigned*)((const char*)(gbase) + (voff)[_i]), (PG8_LAS unsigned*)(lds + (bufoff) + ldsw + _i * 8192), 16, 0, 0); } while (0)
#define PG8_LDA(dst, b, h) do { _Pragma("unroll") for (int m = 0; m < 4; ++m) _Pragma("unroll") for (int k = 0; k < 2; ++k) dst[m][k] = *(const PG8_LAS bf16x8*)(lds + PG8_SA(b, h) + aoff + m * 2048 + k * 1024); } while (0)
#define PG8_LDB(dst, b, h) do { _Pragma("unroll") for (int n = 0; n < 2; ++n) _Pragma("unroll") for (int k = 0; k < 2; ++k) dst[n][k] = *(const PG8_LAS bf16x8*)(lds + PG8_SB(b, h) + boff + n * 2048 + k * 1024); } while (0)
#define PG8_MMA(ai, bj, At, Bt) do { __builtin_amdgcn_s_setprio(1); _Pragma("unroll") for (int m = 0; m < 4; ++m) _Pragma("unroll") for (int n = 0; n < 2; ++n) _Pragma("unroll") for (int k = 0; k < 2; ++k) \
        acc[ai][bj][m][n] = __builtin_amdgcn_mfma_f32_16x16x32_bf16(Bt[n][k], At[m][k], acc[ai][bj][m][n], 0, 0, 0); __builtin_amdgcn_s_setprio(0); } while (0)
#define PG8_WAIT_V(n) asm volatile("s_waitcnt vmcnt(" #n ")" ::: "memory")
#define PG8_WAIT_L(n) asm volatile("s_waitcnt lgkmcnt(" #n ")" ::: "memory")
#define PG8_BAR __builtin_amdgcn_s_barrier()
#define PG8_SCHED __builtin_amdgcn_sched_barrier(0)
    Unit cur, nxt; int ui = 0;
    if (!S.next(0, cur)) return;
    f32x4 acc[2][2][4][2];
#pragma unroll
    for (int a = 0; a < 2; ++a)
#pragma unroll
        for (int b = 0; b < 2; ++b)
#pragma unroll
            for (int m = 0; m < 4; ++m)
#pragma unroll
                for (int n = 0; n < 2; ++n) acc[a][b][m][n] = (f32x4){0.f, 0.f, 0.f, 0.f};
    bf16x8 At[4][2], B0[2][2], B1[2][2];
    const char* cA = (const char*)g.A + (size_t)cur.pm * tstep; const char* cB = (const char*)g.Bt + (size_t)cur.pn * tstep;
    S.a_ready(cur);
    if constexpr (SP2) {
        PG8_STAGE(PG8_SB(0, 0), cB, voffB); PG8_STAGE(PG8_SB(0, 1), cB + hstep, voffB); PG8_STAGE(PG8_SA(0, 0), cA, voffA); PG8_STAGE(PG8_SA(0, 1), cA + hstep, voffA);
        if (wr == 1) PG8_BAR;
        PG8_WAIT_V(2); PG8_BAR;
        PG8_STAGE(PG8_SB(1, 0), cB + kstep, voffB); PG8_STAGE(PG8_SA(1, 0), cA + kstep, voffA); PG8_STAGE(PG8_SB(1, 1), cB + hstep + kstep, voffB);
        PG8_WAIT_V(6); PG8_BAR;
    } else {
        PG8_STAGE(PG8_SB(0, 0), cB, voffB); PG8_STAGE(PG8_SA(0, 0), cA, voffA); PG8_STAGE(PG8_SB(0, 1), cB + hstep, voffB); PG8_STAGE(PG8_SA(0, 1), cA + hstep, voffA);
        if (wr == 1) PG8_BAR;
        PG8_WAIT_V(4); PG8_BAR;
        PG8_STAGE(PG8_SB(1, 0), cB + kstep, voffB); PG8_STAGE(PG8_SA(1, 0), cA + kstep, voffA); PG8_STAGE(PG8_SB(1, 1), cB + hstep + kstep, voffB);
        PG8_WAIT_V(6); PG8_BAR;
    }
    for (;;) {
        const bool has_next = S.next(ui + 1, nxt);
        const char* nA = has_next ? (const char*)g.A + (size_t)nxt.pm * tstep : cA; const char* nB = has_next ? (const char*)g.Bt + (size_t)nxt.pn * tstep : cB;
        for (int t = 0; t < nt; t += 2) {
            const bool last = (t == nt - 2);
            const char* a1 = cA + (size_t)(t + 1) * kstep;
            const char* a2 = last ? nA : cA + (size_t)(t + 2) * kstep; const char* b2 = last ? nB : cB + (size_t)(t + 2) * kstep;
            const char* a3 = a2 + kstep; const char* b3 = b2 + kstep;
            if (last && has_next) S.a_ready(nxt);
            if constexpr (SP2) {
            PG8_LDB(B0, 0, 0); PG8_LDB(B1, 0, 1); PG8_SCHED; PG8_LDA(At, 0, 0); PG8_STAGE(PG8_SA(1, 1), a1 + hstep, voffA);
            PG8_WAIT_V(8); PG8_WAIT_L(0); PG8_BAR; PG8_MMA(0, 0, At, B0); PG8_MMA(0, 1, At, B1); PG8_BAR; PG8_SCHED;
            PG8_LDA(At, 0, 1); PG8_STAGE(PG8_SB(0, 0), b2, voffB); PG8_STAGE(PG8_SB(0, 1), b2 + hstep, voffB); PG8_STAGE(PG8_SA(0, 0), a2, voffA);
            PG8_WAIT_V(8); PG8_WAIT_L(0); PG8_BAR; PG8_MMA(1, 0, At, B0); PG8_MMA(1, 1, At, B1); PG8_BAR; PG8_SCHED;
            PG8_LDB(B0, 1, 0); PG8_LDB(B1, 1, 1); PG8_SCHED; PG8_LDA(At, 1, 0); PG8_STAGE(PG8_SA(0, 1), a2 + hstep, voffA);
            PG8_WAIT_V(8); PG8_WAIT_L(0); PG8_BAR; PG8_MMA(0, 0, At, B0); PG8_MMA(0, 1, At, B1); PG8_BAR; PG8_SCHED;
            PG8_LDA(At, 1, 1); PG8_STAGE(PG8_SB(1, 0), b3, voffB); PG8_STAGE(PG8_SB(1, 1), b3 + hstep, voffB); PG8_STAGE(PG8_SA(1, 0), a3, voffA);
            PG8_WAIT_V(8); PG8_WAIT_L(0); PG8_BAR; PG8_MMA(1, 0, At, B0); PG8_MMA(1, 1, At, B1); PG8_BAR; PG8_SCHED;
            } else {
            PG8_LDB(B0, 0, 0); PG8_SCHED; PG8_LDA(At, 0, 0); PG8_STAGE(PG8_SA(1, 1), a1 + hstep, voffA);
            PG8_WAIT_L(8); PG8_BAR; PG8_WAIT_L(0); PG8_MMA(0, 0, At, B0); PG8_BAR; PG8_SCHED;
            PG8_LDB(B1, 0, 1); PG8_STAGE(PG8_SB(0, 0), b2, voffB);
            PG8_BAR; PG8_WAIT_L(0); PG8_MMA(0, 1, At, B1); PG8_BAR;
            PG8_LDA(At, 0, 1); PG8_STAGE(PG8_SA(0, 0), a2, voffA);
            PG8_BAR; PG8_WAIT_L(0); PG8_MMA(1, 0, At, B0); PG8_BAR; PG8_SCHED;
            PG8_STAGE(PG8_SB(0, 1), b2 + hstep, voffB);
            PG8_WAIT_V(6); PG8_BAR; PG8_MMA(1, 1, At, B1); PG8_BAR;
            PG8_LDB(B0, 1, 0); PG8_SCHED; PG8_LDA(At, 1, 0); PG8_STAGE(PG8_SA(0, 1), a2 + hstep, voffA);
            PG8_WAIT_L(8); PG8_BAR; PG8_WAIT_L(0); PG8_MMA(0, 0, At, B0); PG8_BAR; PG8_SCHED;
            PG8_LDB(B1, 1, 1); PG8_STAGE(PG8_SB(1, 0), b3, voffB);
            PG8_BAR; PG8_WAIT_L(0); PG8_MMA(0, 1, At, B1); PG8_BAR;
            PG8_LDA(At, 1, 1); PG8_STAGE(PG8_SA(1, 0), a3, voffA);
            PG8_BAR; PG8_WAIT_L(0); PG8_MMA(1, 0, At, B0); PG8_BAR; PG8_SCHED;
            PG8_STAGE(PG8_SB(1, 1), b3 + hstep, voffB);
            PG8_WAIT_V(6); PG8_BAR; PG8_MMA(1, 1, At, B1); PG8_BAR;
            }
            if constexpr (Epi::HAS_MID) { if (t == nt / 2 - 2) E.mid(acc, wr, fr); }
        }
        if constexpr (ALIGN_EPI) { if (wr == 0) PG8_BAR; }
        if constexpr (!Epi::AFTER_DRAIN) { E(acc, cur, wr, wc, fr, fq); S.done(cur); }
        if (!has_next) break;
#pragma unroll
        for (int a = 0; a < 2; ++a)
#pragma unroll
            for (int b = 0; b < 2; ++b)
#pragma unroll
                for (int m = 0; m < 4; ++m)
#pragma unroll
                    for (int n = 0; n < 2; ++n) acc[a][b][m][n] = (f32x4){0.f, 0.f, 0.f, 0.f};
        cur = nxt; cA = nA; cB = nB; ++ui;
        if constexpr (ALIGN_EPI) { if (wr == 1) PG8_BAR; }
    }
    PG8_WAIT_V(0);
    if constexpr (!ALIGN_EPI) { if (wr == 0) PG8_BAR; }
    PG8_BAR;
    if constexpr (Epi::AFTER_DRAIN) { E.fused(acc, cur, wr, wc, fr, fq, lds, wid, lane); S.done(cur); }
#undef PG8_SA
#undef PG8_SB
#undef PG8_STAGE
#undef PG8_LDA
#undef PG8_LDB
#undef PG8_MMA
#undef PG8_WAIT_V
#undef PG8_WAIT_L
#undef PG8_BAR
#undef PG8_SCHED
}
}


constexpr int NWAVES = 8;
#ifndef MK_MODE
#define MK_MODE 0
#endif
#ifndef NAIVE_MOBA
#define NAIVE_MOBA 0
#endif
#ifndef NAIVE_SB
#define NAIVE_SB 0
#endif
constexpr int N_PHASES = 7;

constexpr int BATCH = 4, SEQ = 2048, DM = 2048, NH = 8, HD = 128, DG = 1024, DQKV = 6144, DFF = 8192, M = BATCH * SEQ;
constexpr float EPS = 1e-6f;
constexpr float C2 = pg8::P_C2;

constexpr size_t MiB = 1u << 20;
constexpr size_t WS_CTL = 0, CTL_ZERO_BYTES = 256 * 1024;
constexpr size_t WS_KMEAN = 128 * 1024;
constexpr size_t WS_R0 = 256 * 1024;
constexpr size_t WS_ROPE = 320 * 1024;
constexpr size_t WS_SSQA = 576 * 1024;
constexpr size_t WS_SSQB = 832 * 1024;
constexpr size_t WS_SSQ1 = 1088 * 1024;
constexpr size_t WS_SSQ2 = 1344 * 1024;
constexpr size_t WS_WOUT = 2 * MiB, WS_WUP = 10 * MiB, WS_WDOWN = 42 * MiB;
constexpr size_t WS_X1B = 74 * MiB;
constexpr size_t WS_R = 106 * MiB;
constexpr size_t WS_WIN = WS_R, WS_O = WS_R, WS_QKV = WS_R + 32 * MiB, WS_ACT = WS_R, WS_END = 234 * MiB;
static_assert(WS_QKV + (size_t)6 * M * DG * 2 == WS_END && WS_ACT + (size_t)M * DFF * 2 == WS_END && WS_SSQ2 + 8 * M * 4 <= WS_WOUT, "d_ws map");
constexpr int CW_BAR = 1024;

constexpr int RING_OFF = 0, RING_BYTES = 131072;
constexpr int TAB_OFF = RING_BYTES;
constexpr int PST_OFF = TAB_OFF + 2048;
constexpr int LDSCTL_OFF = PST_OFF + 4096, MISC_OFF = LDSCTL_OFF + 320;
constexpr int LDS_BYTES = 147456;
static_assert(MISC_OFF + 128 <= LDS_BYTES, "LDS map");

#define GAS __attribute__((address_space(1)))
#define LAS __attribute__((address_space(3)))
typedef unsigned short bf16;
typedef unsigned v4u __attribute__((ext_vector_type(4)));
typedef float f32x4 __attribute__((ext_vector_type(4)));
typedef short bf16x8 __attribute__((ext_vector_type(8)));
typedef GAS unsigned gu32;
typedef GAS unsigned long long gu64;
#define RLX_AGENT __ATOMIC_RELAXED, __HIP_MEMORY_SCOPE_AGENT
#define LDS_WAIT() asm volatile("s_waitcnt lgkmcnt(0)" ::: "memory")
#define VM_WAIT() asm volatile("s_waitcnt vmcnt(0)" ::: "memory")
__device__ __forceinline__ unsigned long long rt() { return __builtin_amdgcn_s_memrealtime(); }
__device__ __forceinline__ unsigned f2bf(float f) { unsigned u = __builtin_bit_cast(unsigned, f); return (u + 0x7fffu + ((u >> 16) & 1u)) >> 16; }
__device__ __forceinline__ unsigned pk2(float lo, float hi) { return f2bf(lo) | (f2bf(hi) << 16); }

#define XB_TMO      128
#define XB_XCNT(j)  (256  + 64 * (j))
#define XB_XSUB(j)  (1280 + 64 * (j))
#define XB_XGEN(j)  (2304 + 64 * (j))
#define XB_TOP      3328
#define XB_TOPGEN   3392
#define XCD_BAR_WORDS 3456
#define XB_SPIN_CAP (1u << 18)

__device__ __forceinline__ unsigned xb_ld(unsigned* p)              { return __hip_atomic_load(p, __ATOMIC_RELAXED, __HIP_MEMORY_SCOPE_AGENT); }
__device__ __forceinline__ unsigned xb_add(unsigned* p, unsigned v) { return __hip_atomic_fetch_add(p, v, __ATOMIC_RELAXED, __HIP_MEMORY_SCOPE_AGENT); }
__device__ __forceinline__ unsigned xb_xcc_id() { return (unsigned)__builtin_amdgcn_s_getreg((3 << 11) | 20) & 0xFu; }
#define XB_SPIN(cond, bar) do { unsigned _sp = 0; while (cond) { __builtin_amdgcn_s_sleep(1); \
    if ((++_sp & 255u) == 0u) { if (xb_ld(&(bar)[XB_TMO])) break; if (_sp > XB_SPIN_CAP) { atomicAdd(&(bar)[XB_TMO], 1u); break; } } } } while (0)

struct XcdBarrier {
    unsigned* bar; unsigned x;
    volatile LAS unsigned* st;
};

__device__ __forceinline__ XcdBarrier xcd_barrier_post(unsigned* bar, volatile LAS unsigned* st) {
    XcdBarrier b; b.bar = bar; b.x = xb_xcc_id(); b.st = st;
    if (threadIdx.x == 0) (void)xb_add(&bar[XB_XCNT(b.x)], 1u);
    return b;
}
__device__ __forceinline__ void xcd_barrier_complete(unsigned* bar, unsigned x, unsigned& nloc, unsigned& nx) {
    const unsigned G = gridDim.x * gridDim.y * gridDim.z;
    unsigned sum, cnt, mine, sp = 0u;
    for (;;) {
        sum = 0u; cnt = 0u; mine = 0u;
#pragma unroll
        for (unsigned j = 0; j < 16; ++j) { const unsigned c = xb_ld(&bar[XB_XCNT(j)]); sum += c; cnt += (c > 0u) ? 1u : 0u; mine = (j == x) ? c : mine; }
        if (sum == G) break;
        __builtin_amdgcn_s_sleep(1);
        if ((++sp & 255u) == 0u) { if (xb_ld(&bar[XB_TMO])) break; if (sp > XB_SPIN_CAP) { atomicAdd(&bar[XB_TMO], 1u); break; } }
    }
    nloc = mine > 0u ? mine : 1u; nx = cnt > 0u ? cnt : 1u;
}

__device__ __forceinline__ void xcd_barrier(const XcdBarrier& b) {
    asm volatile("s_waitcnt vmcnt(0)" ::: "memory");
    __syncthreads();
    if (threadIdx.x == 0) {
        unsigned* bar = b.bar;
        __builtin_amdgcn_s_waitcnt(0);
        unsigned nloc = b.st[0], nx = b.st[1];
        if (nloc == 0u) { xcd_barrier_complete(bar, b.x, nloc, nx); b.st[0] = nloc; b.st[1] = nx; }
        const unsigned old = xb_add(&bar[XB_XSUB(b.x)], 1u);
        const unsigned gen = old / nloc;
        if (old + 1u == (gen + 1u) * nloc) {
            __builtin_amdgcn_fence(__ATOMIC_RELEASE, "agent");
            asm volatile("s_waitcnt vmcnt(0)" ::: "memory");
            const unsigned og = xb_add(&bar[XB_TOP], 1u);
            const unsigned tg = og / nx;
            if (og + 1u == (tg + 1u) * nx) xb_add(&bar[XB_TOPGEN], 1u);
            else XB_SPIN(xb_ld(&bar[XB_TOPGEN]) == tg, bar);
            __builtin_amdgcn_fence(__ATOMIC_ACQUIRE, "agent");
            xb_add(&bar[XB_XGEN(b.x)], 1u);
            asm volatile("s_waitcnt vmcnt(0)" ::: "memory");
        } else {
            XB_SPIN(xb_ld(&bar[XB_XGEN(b.x)]) == gen, bar);
            __builtin_amdgcn_fence(__ATOMIC_ACQUIRE, "agent");
            asm volatile("s_waitcnt vmcnt(0)" ::: "memory");
        }
    }
    __syncthreads();
}


struct Frame {
    LAS unsigned char* lds;
    volatile LAS unsigned* MISC;
    gu32* ctl;
    int tid, lane, wave;
    int vcu, G;
};

__device__ __forceinline__ float wave_sum(float v) {
#pragma unroll
    for (int o = 1; o < 64; o <<= 1) v += __shfl_xor(v, o);
    return v;
}
__device__ __forceinline__ float wave_max(float v) {
#pragma unroll
    for (int o = 1; o < 64; o <<= 1) v = fmaxf(v, __shfl_xor(v, o));
    return v;
}
__device__ __forceinline__ float bf2f(unsigned short h) { return __uint_as_float((unsigned)h << 16); }

__device__ __forceinline__ void p0_transpose_item(const float* W, const float* g, int K, int N, bf16* WT, LAS float* scr, int item, int lane) {
    const int nblk = N / 32, kb = item / nblk, nb = item % nblk, k0 = 64 * kb, n0 = 32 * nb;
#pragma unroll 8
    for (int i = 0; i < 32; ++i) { const int kk = 2 * i + (lane >> 5); const float gv = g ? g[k0 + kk] : 1.f; scr[kk * 33 + (lane & 31)] = W[(size_t)(k0 + kk) * N + n0 + (lane & 31)] * gv; }
    LDS_WAIT(); asm volatile("" ::: "memory");
    const int c = lane & 7;
#pragma unroll
    for (int j = 0; j < 4; ++j) { const int n = (lane >> 3) + 8 * j; const LAS float* s = scr + (8 * c) * 33 + n;
        v4u o; o.x = pk2(s[0 * 33], s[1 * 33]); o.y = pk2(s[2 * 33], s[3 * 33]); o.z = pk2(s[4 * 33], s[5 * 33]); o.w = pk2(s[6 * 33], s[7 * 33]);
        *(GAS v4u*)(WT + (size_t)(n0 + n) * K + k0 + 8 * c) = o; }
    LDS_WAIT(); asm volatile("" ::: "memory");
}

struct Args { const float* in[10]; float* out; unsigned char* ws; int ph_lo, ph_hi, li, pad; };

__global__ void __launch_bounds__(256) naive_moba(const bf16* __restrict__ Q, const bf16* __restrict__ K, const bf16* __restrict__ V, const float* __restrict__ kmean, bf16* O, float* ssq) {
    __shared__ float qs[4][128];
    const int tid = threadIdx.x, lane = tid & 63, w = tid >> 6; const int gw = blockIdx.x * 4 + w;
    const int bh = gw / SEQ, t = gw % SEQ, b = bh / NH, h = bh % NH, blk_i = t >> 8;
    const bf16* qrow = Q + ((size_t)bh * SEQ + t) * HD;
    const float q0 = bf2f(qrow[2 * lane]), q1 = bf2f(qrow[2 * lane + 1]);
    qs[w][2 * lane] = q0; qs[w][2 * lane + 1] = q1;
    __syncthreads();
    float gate[8];
#pragma unroll
    for (int j = 0; j < 8; ++j) { const float* km = kmean + ((size_t)bh * 8 + j) * HD; gate[j] = wave_sum(q0 * km[2 * lane] + q1 * km[2 * lane + 1]); }
    unsigned sel = 0;
#pragma unroll
    for (int j = 0; j < 8; ++j) { int rank = 0;
#pragma unroll
        for (int jj = 0; jj < 8; ++jj) if (jj < blk_i && (gate[jj] > gate[j] || (gate[jj] == gate[j] && jj < j))) ++rank;
        if (j < blk_i && rank < 3) sel |= 1u << j; }
    sel |= 1u << blk_i;
    float m = -1e30f, l = 0.f, o0 = 0.f, o1 = 0.f;
    for (int j = 0; j <= blk_i; ++j) {
        if (!((sel >> j) & 1u)) continue;
        for (int c = 0; c < 4; ++c) {
            const int key = j * 256 + c * 64 + lane; const bf16* krow = K + ((size_t)bh * SEQ + key) * HD;
            float s = 0.f;
            for (int d = 0; d < 128; d += 8) { const v4u kk = *(const v4u*)(krow + d);
                s += qs[w][d] * __uint_as_float(kk.x << 16) + qs[w][d + 1] * __uint_as_float(kk.x & 0xffff0000u) + qs[w][d + 2] * __uint_as_float(kk.y << 16) + qs[w][d + 3] * __uint_as_float(kk.y & 0xffff0000u)
                   + qs[w][d + 4] * __uint_as_float(kk.z << 16) + qs[w][d + 5] * __uint_as_float(kk.z & 0xffff0000u) + qs[w][d + 6] * __uint_as_float(kk.w << 16) + qs[w][d + 7] * __uint_as_float(kk.w & 0xffff0000u); }
            if (key > t) s = -__builtin_inff();
            const float cm = wave_max(s), mn = fmaxf(m, cm), alpha = exp2f(m - mn), p = exp2f(s - mn);
            l = l * alpha + wave_sum(p); o0 *= alpha; o1 *= alpha; m = mn;
            for (int kk = 0; kk < 64; ++kk) { const float pk = __shfl(p, kk); const bf16* vrow = V + ((size_t)bh * SEQ + j * 256 + c * 64 + kk) * HD;
                const unsigned vv = *(const unsigned*)(vrow + 2 * lane); o0 += pk * __uint_as_float(vv << 16); o1 += pk * __uint_as_float(vv & 0xffff0000u); }
        }
    }
    o0 /= l; o1 /= l;
    *(unsigned*)(O + ((size_t)b * SEQ + t) * DM + h * HD + 2 * lane) = pk2(o0, o1);
    const float ss = wave_sum(o0 * o0 + o1 * o1);
    if (lane == 0) ssq[(size_t)h * M + b * SEQ + t] = ss;
}
__global__ void __launch_bounds__(256) naive_sb(const bf16* __restrict__ Q, const bf16* __restrict__ K, const bf16* __restrict__ V, bf16* O, float* ssq) {
    __shared__ float qs[4][128];
    const int tid = threadIdx.x, lane = tid & 63, w = tid >> 6; const int gw = blockIdx.x * 4 + w;
    const int bh = gw / SEQ, t = gw % SEQ, b = bh / NH, h = bh % NH;
    const bf16* qrow = Q + ((size_t)bh * SEQ + t) * HD;
    qs[w][2 * lane] = bf2f(qrow[2 * lane]); qs[w][2 * lane + 1] = bf2f(qrow[2 * lane + 1]);
    __syncthreads();
    float R = 0.f, o0 = 0.f, o1 = 0.f;
    for (int hi = t - 1; hi >= 0; hi -= 64) {
        const int key = hi - lane; const bool valid = key >= 0; const int kc = valid ? key : 0;
        const bf16* krow = K + ((size_t)bh * SEQ + kc) * HD;
        float s = 0.f;
        for (int d = 0; d < 128; d += 8) { const v4u kk = *(const v4u*)(krow + d);
            s += qs[w][d] * __uint_as_float(kk.x << 16) + qs[w][d + 1] * __uint_as_float(kk.x & 0xffff0000u) + qs[w][d + 2] * __uint_as_float(kk.y << 16) + qs[w][d + 3] * __uint_as_float(kk.y & 0xffff0000u)
               + qs[w][d + 4] * __uint_as_float(kk.z << 16) + qs[w][d + 5] * __uint_as_float(kk.z & 0xffff0000u) + qs[w][d + 6] * __uint_as_float(kk.w << 16) + qs[w][d + 7] * __uint_as_float(kk.w & 0xffff0000u); }
        float l2 = valid ? -(fmaxf(s, 0.f) + log2f(1.0f + exp2f(-fabsf(s)))) : 0.f;
        float pre = l2;
#pragma unroll
        for (int o = 1; o < 64; o <<= 1) { const float up = __shfl_up(pre, o); if (lane >= o) pre += up; }
        const float a = valid ? exp2f(s + R + pre) : 0.f;
        R += __shfl(pre, 63);
        for (int kk = 0; kk < 64; ++kk) { if (hi - kk < 0) break; const float ak = __shfl(a, kk); const bf16* vrow = V + ((size_t)bh * SEQ + hi - kk) * HD;
            const unsigned vv = *(const unsigned*)(vrow + 2 * lane); o0 += ak * __uint_as_float(vv << 16); o1 += ak * __uint_as_float(vv & 0xffff0000u); }
    }
    *(unsigned*)(O + ((size_t)b * SEQ + t) * DM + DG + h * HD + 2 * lane) = pk2(o0, o1);
    const float ss = wave_sum(o0 * o0 + o1 * o1);
    if (lane == 0) ssq[(size_t)h * M + b * SEQ + t] = ss;
}

namespace att {
typedef short bf16x8 __attribute__((ext_vector_type(8)));
typedef short s16x4 __attribute__((ext_vector_type(4)));
typedef float f32x16 __attribute__((ext_vector_type(16)));
typedef unsigned u32x4 __attribute__((ext_vector_type(4)));
constexpr int QBLK = 32, KVBLK = 64, QB = 256, D = 128;
constexpr int SHM_V = KVBLK * D * 2, SHM_K = KVBLK * D * 2;
constexpr int A_V = 0, A_K = 2 * SHM_V, A_WS = 2 * SHM_V + 2 * SHM_K, A_KM = A_WS + 8 * 64 * 4, A_END = A_KM + 8 * 128 * 4;
static_assert(A_END <= RING_BYTES, "attention LDS inside the ring region");
#define KSWZ(row, colB) ((row) * 256 + ((colB) ^ (((row) & 7) << 4)))
#define SBAR() __builtin_amdgcn_sched_barrier(0)
__device__ __forceinline__ int v_st(int k, int c) { const int kk = (k & ~0xC) | ((k & 4) << 1) | ((k & 8) >> 1); return ((kk >> 3) * 4 + (c >> 5)) * 512 + ((kk & 7) * 32 + (c & 31)) * 2; }
__device__ __forceinline__ int v_rd_base(int lane) { return ((lane & 3) << 3) | (((lane >> 2) & 3) << 6) | (((lane >> 4) & 1) << 5) | (((lane >> 5) & 1) << 8); }
constexpr int v_rd_off(int d0, int ks, int half) { return d0 * 512 + ks * 4096 + half * 2048; }
__device__ __forceinline__ int crow(int r, int hi) { return (r & 3) + 8 * (r >> 2) + 4 * hi; }
__device__ __forceinline__ unsigned cvtpk(float lo, float hi) { unsigned r; asm volatile("v_cvt_pk_bf16_f32 %0, %1, %2" : "=v"(r) : "v"(lo), "v"(hi)); return r; }
__device__ __forceinline__ float xchg32(float v, bool upper) {
    auto r = __builtin_amdgcn_permlane32_swap(__float_as_uint(v), __float_as_uint(v), false, false);
    return __uint_as_float(upper ? r[0] : r[1]);
}
__device__ __forceinline__ void qkt(f32x16& p0, f32x16& p1, const char* kbuf, int r32, int hi, const bf16x8* qr) {
    p0 = f32x16{}; p1 = f32x16{};
    const char* kb[4];
#pragma unroll
    for (int dd = 0; dd < 4; ++dd) kb[dd] = kbuf + KSWZ(r32, (dd * 16 + hi * 8) * 2);
#pragma unroll
    for (int d0 = 0; d0 < 8; ++d0) { const char* a = kb[d0 & 3] + (d0 >> 2) * 128;
        bf16x8 b0 = *reinterpret_cast<const bf16x8*>(a);
        bf16x8 b1 = *reinterpret_cast<const bf16x8*>(a + 32 * 256);
        p0 = __builtin_amdgcn_mfma_f32_32x32x16_bf16(b0, qr[d0], p0, 0, 0, 0);
        p1 = __builtin_amdgcn_mfma_f32_32x32x16_bf16(b1, qr[d0], p1, 0, 0, 0); }
}
__device__ __forceinline__ void qkt1(f32x16& p, const char* kbuf, int half, int r32, int hi, const bf16x8* qr) {
    p = f32x16{};
    const char* kb[4];
#pragma unroll
    for (int dd = 0; dd < 4; ++dd) kb[dd] = kbuf + half * (32 * 256) + KSWZ(r32, (dd * 16 + hi * 8) * 2);
#pragma unroll
    for (int d0 = 0; d0 < 8; ++d0) { const bf16x8 b0 = *reinterpret_cast<const bf16x8*>(kb[d0 & 3] + (d0 >> 2) * 128);
        p = __builtin_amdgcn_mfma_f32_32x32x16_bf16(b0, qr[d0], p, 0, 0, 0); }
}
#define PK4(P, B_, OUT) do { unsigned a0 = cvtpk(P[B_+0], P[B_+1]), a1 = cvtpk(P[B_+2], P[B_+3]);                          \
        unsigned b0 = cvtpk(P[B_+4], P[B_+5]), b1 = cvtpk(P[B_+6], P[B_+7]);                                             \
        auto r0 = __builtin_amdgcn_permlane32_swap(a0, b0, false, false); auto r1 = __builtin_amdgcn_permlane32_swap(a1, b1, false, false); \
        u32x4 w = {r0[0], r1[0], r0[1], r1[1]}; OUT = *reinterpret_cast<bf16x8*>(&w); } while (0)
__device__ __forceinline__ void pack_h(const f32x16& p, bf16x8& pa, bf16x8& pb) { PK4(p, 0, pa); PK4(p, 8, pb); }
#undef PK4
__device__ __forceinline__ void pv_tile(f32x16* o, int vb0, bf16x8 pa0, bf16x8 pa1, bf16x8 pa2, bf16x8 pa3) {
#define TRRD(dst, off) asm volatile("ds_read_b64_tr_b16 %0, %1 offset:%2" : "=&v"(dst) : "v"(vb0), "i"(off) : "memory")
#define PV_D0(d0) do { s16x4 l0, l1, l2, l3, h0, h1, h2, h3; constexpr int b_ = v_rd_off(d0, 0, 0); \
        TRRD(l0, b_); TRRD(h0, b_ + 2048); TRRD(l1, b_ + 4096); TRRD(h1, b_ + 6144); TRRD(l2, b_ + 8192); TRRD(h2, b_ + 10240); TRRD(l3, b_ + 12288); TRRD(h3, b_ + 14336); \
        asm volatile("s_waitcnt lgkmcnt(0)" ::: "memory"); SBAR(); \
        o[d0] = __builtin_amdgcn_mfma_f32_32x32x16_bf16(pa0, (bf16x8){l0[0], l0[1], l0[2], l0[3], h0[0], h0[1], h0[2], h0[3]}, o[d0], 0, 0, 0);   \
        o[d0] = __builtin_amdgcn_mfma_f32_32x32x16_bf16(pa1, (bf16x8){l1[0], l1[1], l1[2], l1[3], h1[0], h1[1], h1[2], h1[3]}, o[d0], 0, 0, 0);   \
        o[d0] = __builtin_amdgcn_mfma_f32_32x32x16_bf16(pa2, (bf16x8){l2[0], l2[1], l2[2], l2[3], h2[0], h2[1], h2[2], h2[3]}, o[d0], 0, 0, 0);   \
        o[d0] = __builtin_amdgcn_mfma_f32_32x32x16_bf16(pa3, (bf16x8){l3[0], l3[1], l3[2], l3[3], h3[0], h3[1], h3[2], h3[3]}, o[d0], 0, 0, 0); } while (0)
    PV_D0(0); PV_D0(1); PV_D0(2); PV_D0(3);
#undef PV_D0
#undef TRRD
}
__device__ __forceinline__ void pack_p(const f32x16& p0, const f32x16& p1, bf16x8& pa0, bf16x8& pa1, bf16x8& pa2, bf16x8& pa3) {
#define PK4(P, B_, OUT) do { unsigned a0 = cvtpk(P[B_+0], P[B_+1]), a1 = cvtpk(P[B_+2], P[B_+3]);                          \
        unsigned b0 = cvtpk(P[B_+4], P[B_+5]), b1 = cvtpk(P[B_+6], P[B_+7]);                                             \
        auto r0 = __builtin_amdgcn_permlane32_swap(a0, b0, false, false); auto r1 = __builtin_amdgcn_permlane32_swap(a1, b1, false, false); \
        u32x4 w = {r0[0], r1[0], r0[1], r1[1]}; OUT = *reinterpret_cast<bf16x8*>(&w); } while (0)
    PK4(p0, 0, pa0); PK4(p0, 8, pa1); PK4(p1, 0, pa2); PK4(p1, 8, pa3);
#undef PK4
}
template <bool MASK>
__device__ __forceinline__ void sb_half(f32x16& P, float& R, int dq  , int hi) {
    float suf[16], T[4];
#pragma unroll
    for (int g = 0; g < 4; ++g) {
        float run = 0.f;
#pragma unroll
        for (int e = 3; e >= 0; --e) { const int r = 4 * g + e; const float z = P[r]; const float sp = __builtin_amdgcn_logf(1.0f + __builtin_amdgcn_exp2f(-fabsf(z)));
            float l = -(fmaxf(z, 0.f) + sp);
            if (MASK) { const int c = e + 8 * g; if (!(c < dq)) l = 0.f; }
            run += l; suf[r] = run; }
        T[g] = run;
    }
    float Tp[4], E[4];
#pragma unroll
    for (int g = 0; g < 4; ++g) Tp[g] = xchg32(T[g], hi != 0);
    E[3] = R; E[2] = E[3] + (T[3] + Tp[3]); E[1] = E[2] + (T[2] + Tp[2]); E[0] = E[1] + (T[1] + Tp[1]); R = E[0] + (T[0] + Tp[0]);
#pragma unroll
    for (int g = 0; g < 4; ++g) { const float off = E[g] + (hi == 0 ? Tp[g] : 0.f);
#pragma unroll
        for (int e = 0; e < 4; ++e) { const int r = 4 * g + e; float a = __builtin_amdgcn_exp2f(P[r] + (off + suf[r]));
            if (MASK) { const int c = e + 8 * g; if (!(c < dq)) a = 0.f; }
            P[r] = a; } }
}

template <int GROUP>
__device__ __forceinline__ void attn_unit(int qb, const bf16* Qh, const bf16* Kh, const bf16* Vh, const float* km  , bf16* O, float* ssq, char* lds) {
    int tid_ = threadIdx.x; asm volatile("" : "+v"(tid_));
    const int tid = tid_, wid = __builtin_amdgcn_readfirstlane(tid >> 6), lane = tid & 63, r32 = lane & 31, hi = lane >> 5;
    char* V_lds = lds + A_V; char* K_lds = lds + A_K; float* wsf = (float*)(lds + A_WS) + wid * 64; float* kms = (float*)(lds + A_KM);
    const int q0 = qb * QB, qlo = q0 + wid * QBLK, qpos = qlo + r32;
    const int NT = (q0 + QB) / KVBLK;
    const int sr = tid >> 4, sc = (tid & 15) * 8, vst0 = v_st(sr, sc), vst1 = v_st(32 + sr, sc), kws = KSWZ(sr, sc * 2);
    const int vrb = (int)(uintptr_t)V_lds + v_rd_base(lane);
    bf16x8 qr[8];
#pragma unroll
    for (int d0 = 0; d0 < 8; ++d0) qr[d0] = *reinterpret_cast<const bf16x8*>(Qh + (size_t)(qlo + r32) * D + d0 * 16 + hi * 8);
    bf16x8 st_k0, st_k1, st_v0, st_v1;
#define TILE_OF(step) (GROUP == 0 ? (step) : (NT - 1 - (step)))
#define SLOAD(step) do { const size_t k0_ = (size_t)TILE_OF(step) * KVBLK; \
        st_k0 = *reinterpret_cast<const bf16x8*>(Kh + (k0_ + sr) * D + sc); st_k1 = *reinterpret_cast<const bf16x8*>(Kh + (k0_ + 32 + sr) * D + sc); \
        st_v0 = *reinterpret_cast<const bf16x8*>(Vh + (k0_ + sr) * D + sc); st_v1 = *reinterpret_cast<const bf16x8*>(Vh + (k0_ + 32 + sr) * D + sc); } while (0)
#define SWRITE(bf) do { *(bf16x8*)(K_lds + (bf) * SHM_K + kws) = st_k0; *(bf16x8*)(K_lds + (bf) * SHM_K + kws + 32 * 256) = st_k1; \
        *(bf16x8*)(V_lds + (bf) * SHM_V + vst0) = st_v0; *(bf16x8*)(V_lds + (bf) * SHM_V + vst1) = st_v1; } while (0)
    SLOAD(0);
    unsigned sel = 0xffu;
    if (GROUP == 0) {
        kms[tid] = km[tid]; kms[tid + 512] = km[tid + 512];
        __syncthreads();
        float gate[8];
#pragma unroll
        for (int j = 0; j < 8; ++j) { float s = 0.f;
#pragma unroll
            for (int d0 = 0; d0 < 8; ++d0) { const f32x4 ka = *(const f32x4*)(kms + j * 128 + d0 * 16 + hi * 8), kb = *(const f32x4*)(kms + j * 128 + d0 * 16 + hi * 8 + 4);
#pragma unroll
                for (int e = 0; e < 4; ++e) { s += __uint_as_float((unsigned)(unsigned short)qr[d0][e] << 16) * ka[e]; s += __uint_as_float((unsigned)(unsigned short)qr[d0][e + 4] << 16) * kb[e]; } }
            gate[j] = s + xchg32(s, hi != 0); }
        sel = 0u;
#pragma unroll
        for (int j = 0; j < 8; ++j) { int rank = 0;
#pragma unroll
            for (int jj = 0; jj < 8; ++jj) if (jj < qb && (gate[jj] > gate[j] || (gate[jj] == gate[j] && jj < j))) ++rank;
            if (j < qb && rank < 3) sel |= 1u << j; }
    }
    float m_reg = -1e30f, l_reg = 0.f, R = 0.f; f32x16 o[4];
    { float zz = 0.f; asm volatile("" : "+v"(zz));
#pragma unroll
      for (int d_ = 0; d_ < 4; ++d_)
#pragma unroll
          for (int r = 0; r < 16; ++r) o[d_][r] = zz; }
    asm volatile("s_waitcnt vmcnt(0)" ::: "memory"); SWRITE(0);
    __syncthreads();
    for (int step = 0; step < NT; ++step) {
        const int t = TILE_OF(step), kb = t * KVBLK, bf = step & 1;
        if (step + 1 < NT) SLOAD(step + 1);
        const bool act = (GROUP == 0) ? (kb <= qlo + QBLK - 1) : (kb <= qlo);
        if (act) {
            f32x16 p0, p1; bf16x8 pa0, pa1, pa2, pa3;
            if (GROUP == 0) {
                qkt(p0, p1, K_lds + bf * SHM_K, r32, hi, qr);
                const float NEG = -__builtin_inff();
                if (kb < q0) { if (!((sel >> (t >> 2)) & 1u)) {
#pragma unroll
                        for (int r = 0; r < 16; ++r) { p0[r] = NEG; p1[r] = NEG; } } }
                else if (kb + KVBLK - 1 > qlo) { const int dq = qpos - kb - 4 * hi;
#pragma unroll
                    for (int r = 0; r < 16; ++r) { const int c = (r & 3) + 8 * (r >> 2); if (c > dq) p0[r] = NEG; if (c + 32 > dq) p1[r] = NEG; } }
                float pmax = p0[0];
#pragma unroll
                for (int r = 1; r < 16; ++r) pmax = fmaxf(pmax, p0[r]);
#pragma unroll
                for (int r = 0; r < 16; ++r) pmax = fmaxf(pmax, p1[r]);
                pmax = fmaxf(pmax, xchg32(pmax, hi != 0));
                float alpha = 1.f, mn = m_reg;
                if (!__all(pmax - m_reg <= 11.5f)) { mn = fmaxf(m_reg, pmax); alpha = __builtin_amdgcn_exp2f(m_reg - mn); m_reg = mn; }
                float ps = 0.f;
#pragma unroll
                for (int r = 0; r < 16; ++r) { p0[r] = __builtin_amdgcn_exp2f(p0[r] - mn); p1[r] = __builtin_amdgcn_exp2f(p1[r] - mn); ps += p0[r] + p1[r]; }
                ps += xchg32(ps, hi != 0);
                l_reg = l_reg * alpha + ps;
                if (__any(alpha < 1.f)) { if (hi == 0) wsf[r32] = alpha; asm volatile("s_waitcnt lgkmcnt(0)" ::: "memory");
#pragma unroll
                    for (int d_ = 0; d_ < 4; ++d_)
#pragma unroll
                        for (int r = 0; r < 16; ++r) o[d_][r] *= wsf[crow(r, hi)]; }
                pack_p(p0, p1, pa0, pa1, pa2, pa3);
            } else {
                const int dq = qpos - kb - 4 * hi; const bool msk = kb + KVBLK - 1 >= qlo;
                qkt1(p1, K_lds + bf * SHM_K, 1, r32, hi, qr);
                if (msk) sb_half<true>(p1, R, dq - 32, hi); else sb_half<false>(p1, R, 0, hi);
                pack_h(p1, pa2, pa3); SBAR();
                qkt1(p0, K_lds + bf * SHM_K, 0, r32, hi, qr);
                if (msk) sb_half<true>(p0, R, dq, hi); else sb_half<false>(p0, R, 0, hi);
                pack_h(p0, pa0, pa1);
            }
            pv_tile(o, vrb + bf * SHM_V, pa0, pa1, pa2, pa3);
        }
        if (step + 1 < NT) { asm volatile("s_waitcnt vmcnt(0)" ::: "memory"); SWRITE(bf ^ 1); }
        __syncthreads();
    }
    if (GROUP == 0) { if (hi == 0) wsf[32 + r32] = l_reg; asm volatile("s_waitcnt lgkmcnt(0)" ::: "memory"); }
    int hi_e = hi, c_e = r32; asm volatile("" : "+v"(hi_e), "+v"(c_e));
    bf16* Ow = O + (size_t)(qlo + 4 * hi_e) * DM + c_e; float* sq = ssq + qlo + 4 * hi_e;
#pragma unroll
    for (int r = 0; r < 16; ++r) { const int orow = crow(r, hi), or0 = (r & 3) + 8 * (r >> 2); const float rl = (GROUP == 0) ? __builtin_amdgcn_rcpf(wsf[32 + orow]) : 1.f; float ss = 0.f;
#pragma unroll
        for (int d0 = 0; d0 < 4; ++d0) { const float v = o[d0][r] * rl; ss += v * v; const float vn = __shfl_xor(v, 1);
            if ((r32 & 1) == 0) *(unsigned*)(Ow + (size_t)or0 * DM + d0 * 32) = cvtpk(v, vn); }
        ss += __shfl_xor(ss, 1); ss += __shfl_xor(ss, 2); ss += __shfl_xor(ss, 4); ss += __shfl_xor(ss, 8); ss += __shfl_xor(ss, 16);
        if (r32 == 0) sq[or0] = ss; }
    __syncthreads();
#undef TILE_OF
#undef SLOAD
#undef SWRITE
}
#undef KSWZ
#undef SBAR
}

__device__ __forceinline__ void attn_phase(Frame& F, const bf16* QKV, const float* kmean, bf16* OB, float* ssqa, float* ssqb) {
    char* lds = (char*)F.lds + RING_OFF;
    const size_t TS = (size_t)M * DG;
    for (int v = F.vcu; v < 256; v += F.G) {
        const int bh = v >> 3, i = v & 7, b = bh >> 3, h = bh & 7;
        const size_t ho = (size_t)bh * SEQ * HD;
#if !NAIVE_MOBA
        att::attn_unit<0>(i, QKV + ho, QKV + TS + ho, QKV + 2 * TS + ho, kmean + (size_t)bh * 8 * HD, OB + (size_t)b * SEQ * DM + h * HD, ssqa + (size_t)h * M + b * SEQ, lds);
#endif
#if !NAIVE_SB
        att::attn_unit<1>(7 - i, QKV + 3 * TS + ho, QKV + 4 * TS + ho, QKV + 5 * TS + ho, nullptr, OB + (size_t)b * SEQ * DM + DG + h * HD, ssqb + (size_t)h * M + b * SEQ, lds);
#endif
    }
}


__global__ void __launch_bounds__(NWAVES * 64, 2) fwd_megakernel(Args args) {
    extern __shared__ __attribute__((aligned(16))) unsigned char lds[];
    Frame F;
    F.lds = (LAS unsigned char*)lds;
    F.MISC = (volatile LAS unsigned*)(F.lds + MISC_OFF);
    F.tid = threadIdx.x; F.lane = F.tid & 63; F.wave = __builtin_amdgcn_readfirstlane(F.tid >> 6);
    F.G = gridDim.x; { const int bx = blockIdx.x; F.vcu = (F.G % 8 == 0) ? (bx % 8) * (F.G / 8) + bx / 8 : bx; }
    unsigned char* ws = args.ws;
    F.ctl = (gu32*)(ws + WS_CTL);
    const float* x = args.in[0]; const float* mix_g = args.in[1]; const float* w_in = args.in[2]; const float* moba_g = args.in[3]; const float* sb_g = args.in[4];
    const float* w_out = args.in[5]; const float* mlp_g = args.in[6]; const float* w_up = args.in[7]; const float* w_down = args.in[8]; const float* fin_g = args.in[9];
    float* out = args.out;
    bf16* Win_t = (bf16*)(ws + WS_WIN); bf16* Wout_t = (bf16*)(ws + WS_WOUT); bf16* Wup_t = (bf16*)(ws + WS_WUP); bf16* Wdown_t = (bf16*)(ws + WS_WDOWN);
    bf16* XB = (bf16*)out; bf16* X1B = (bf16*)(ws + WS_X1B); bf16* QKV = (bf16*)(ws + WS_QKV); bf16* OB = (bf16*)(ws + WS_O); bf16* ACT = (bf16*)(ws + WS_ACT);
    float* kmean = (float*)(ws + WS_KMEAN); float* r0 = (float*)(ws + WS_R0); float* rope = (float*)(ws + WS_ROPE);
    float* ssqa = (float*)(ws + WS_SSQA); float* ssqb = (float*)(ws + WS_SSQB); float* ssq1 = (float*)(ws + WS_SSQ1); float* ssq2 = (float*)(ws + WS_SSQ2);
    for (int u = F.tid; u < (LDS_BYTES - LDSCTL_OFF) / 4; u += NWAVES * 64) ((LAS unsigned*)(F.lds + LDSCTL_OFF))[u] = 0u;
    __syncthreads();
    XcdBarrier bar; bar.bar = (unsigned*)(F.ctl + CW_BAR); bar.x = 0; bar.st = nullptr;
    if (MK_MODE == 0) bar = xcd_barrier_post((unsigned*)(F.ctl + CW_BAR), F.MISC + 8);
#define GRID_BAR() do { if (MK_MODE == 0) xcd_barrier(bar); } while (0)
    const int lo = args.ph_lo, hi = args.ph_hi;
#define IN(k) (lo <= (k) && (k) < hi)
#define BOTH(k) (IN(k) && IN((k) + 1))
    const int gw = F.vcu * NWAVES + F.wave, NGW = F.G * NWAVES;

    if (IN(0)) {
        LAS float* scr = (LAS float*)(F.lds + RING_OFF + F.wave * 16384);
        constexpr int I_IN = (DM / 64) * (DQKV / 32), I_OUT = (DM / 64) * (DM / 32), I_UP = (DM / 64) * (DFF / 32), I_DN = (DFF / 64) * (DM / 32);
        constexpr int NITEMS = I_IN + I_OUT + I_UP + I_DN;
        for (int it = gw; it < NITEMS; it += NGW) {
            int r = it;
            if (r < I_IN) { p0_transpose_item(w_in, mix_g, DM, DQKV, Win_t, scr, r, F.lane); continue; } r -= I_IN;
            if (r < I_OUT) { const int kb = r / (DM / 32); const float* g = (kb * 64 < DG) ? moba_g : (sb_g - DG); p0_transpose_item(w_out, g, DM, DM, Wout_t, scr, r, F.lane); continue; } r -= I_OUT;
            if (r < I_UP) { p0_transpose_item(w_up, mlp_g, DM, DFF, Wup_t, scr, r, F.lane); continue; } r -= I_UP;
            p0_transpose_item(w_down, nullptr, DFF, DM, Wdown_t, scr, r, F.lane);
        }
        for (int m = gw; m < M; m += NGW) {
            const GAS f32x4* xr = (const GAS f32x4*)(x + (size_t)m * DM) + F.lane; f32x4 v[8]; float s = 0.f;
#pragma unroll
            for (int j = 0; j < 8; ++j) { v[j] = xr[64 * j]; s += (v[j].x * v[j].x + v[j].y * v[j].y) + (v[j].z * v[j].z + v[j].w * v[j].w); }
            s = wave_sum(s);
            if (F.lane == 0) r0[m] = 1.0f / sqrtf(s * (1.0f / DM) + EPS);
            GAS unsigned long long* o8 = (GAS unsigned long long*)(XB + (size_t)m * DM) + F.lane;
#pragma unroll
            for (int j = 0; j < 8; ++j) o8[64 * j] = (unsigned long long)pk2(v[j].x, v[j].y) | ((unsigned long long)pk2(v[j].z, v[j].w) << 32);
        }
        for (int e = blockIdx.x * (NWAVES * 64) + F.tid; e < SEQ * 16; e += F.G * NWAVES * 64) {
            const int pos = e >> 4, j = e & 15;
            const float inv = powf(500000.0f, -(float)j / 16.0f); const float ang = (float)pos * inv;
            const double tw = 6.283185307179586476925; const double a = (double)ang; const double red = a - tw * rint(a / tw); const float rf = (float)red;
            rope[pos * 32 + j] = cosf(rf); rope[pos * 32 + 16 + j] = sinf(rf);
        }
        if (BOTH(0)) GRID_BAR();
    }

    if (IN(1)) {
        pg8::Gemm g{XB, Win_t, M, DQKV, DM}; pg8::StaticOrder S; S.init(M, DQKV, F.G, (int)blockIdx.x);
        pg8::EpiQKV E{QKV, r0, rope, kmean};
        pg8::gemm_phase<pg8::EpiQKV, pg8::StaticOrder, true, true>(F.lds + RING_OFF, g, S, E);
        if (BOTH(1)) GRID_BAR();
    }

    if (IN(2)) {
        attn_phase(F, QKV, kmean, OB, ssqa, ssqb);
        if (BOTH(2)) GRID_BAR();
    }

    if (IN(3)) {
        pg8::Gemm g{OB, Wout_t, M, DM, DM}; pg8::StaticOrder S; S.init(M, DM, F.G, (int)blockIdx.x);
        LAS float* tab = (LAS float*)(F.lds + TAB_OFF); LAS float* P = (LAS float*)(F.lds + PST_OFF);
        pg8::Unit u0;
        if (S.next(0, u0) && F.tid < 256) { const int row = u0.pm * 256 + F.tid; float sa = 0.f, sb = 0.f;
#pragma unroll
            for (int h = 0; h < 8; ++h) { sa += ssqa[(size_t)h * M + row]; sb += ssqb[(size_t)h * M + row]; }
            const float ra = 1.0f / sqrtf(sa * (1.0f / DG) + EPS), rb = 1.0f / sqrtf(sb * (1.0f / DG) + EPS);
            tab[F.tid * 2] = ra / rb; tab[F.tid * 2 + 1] = rb; }
        __syncthreads();
        pg8::EpiOut E{x, out, X1B, ssq1, tab, P};
        pg8::gemm_phase<pg8::EpiOut, pg8::StaticOrder, false, true>(F.lds + RING_OFF, g, S, E);
        if (BOTH(3)) GRID_BAR();
    }

    if (IN(4)) {
        pg8::Gemm g{X1B, Wup_t, M, DFF, DM}; pg8::StaticOrder S; S.init(M, DFF, F.G, (int)blockIdx.x);
        pg8::EpiUp E{ACT, ssq1};
        pg8::gemm_phase<pg8::EpiUp, pg8::StaticOrder, true, true>(F.lds + RING_OFF, g, S, E);
        if (BOTH(4)) GRID_BAR();
    }

    if (IN(5)) {
        pg8::Gemm g{ACT, Wdown_t, M, DM, DFF}; pg8::StaticOrder S; S.init(M, DM, F.G, (int)blockIdx.x);
        LAS float* P = (LAS float*)(F.lds + PST_OFF);
        pg8::EpiDown E{out, ssq2, P};
        pg8::gemm_phase<pg8::EpiDown, pg8::StaticOrder, false, true>(F.lds + RING_OFF, g, S, E);
        if (BOTH(5)) GRID_BAR();
    }

    if (IN(6)) {
        for (int m = gw; m < M; m += NGW) {
            float sq = 0.f;
#pragma unroll
            for (int p = 0; p < 8; ++p) sq += ssq2[(size_t)p * M + m];
            const float r = 1.0f / sqrtf(sq * (1.0f / DM) + EPS);
            GAS f32x4* xr = (GAS f32x4*)(out + (size_t)m * DM) + F.lane; const GAS f32x4* gr = (const GAS f32x4*)fin_g + F.lane;
#pragma unroll
            for (int j = 0; j < 8; ++j) { const f32x4 v = xr[64 * j]; const f32x4 gg = gr[64 * j]; xr[64 * j] = v * r * gg; }
        }
    }
#undef IN
#undef BOTH
}

extern "C" void kernel_launch(void* const* d_in, const int* in_sizes, int n_in, void* d_out, int out_size, void* d_ws, size_t ws_size, hipStream_t stream) {
    static int grid = 0;
    if (grid == 0) {
        if (n_in != 10 || in_sizes[0] != M * DM || out_size != M * DM || ws_size < WS_END) { fprintf(stderr, "kernel_launch: shape/workspace mismatch (n_in %d, in0 %d, out %d, ws %zu)\n", n_in, n_in > 0 ? in_sizes[0] : -1, out_size, ws_size); grid = -1; return; }
        int dev = 0, cus = 0, per_cu = 0;
        if (hipGetDevice(&dev) != hipSuccess || hipDeviceGetAttribute(&cus, hipDeviceAttributeMultiprocessorCount, dev) != hipSuccess) { fprintf(stderr, "kernel_launch: device query failed\n"); grid = -1; return; }
        if (hipFuncSetAttribute((const void*)fwd_megakernel, hipFuncAttributeMaxDynamicSharedMemorySize, LDS_BYTES) != hipSuccess) { fprintf(stderr, "kernel_launch: hipFuncSetAttribute failed\n"); grid = -1; return; }
        if (hipOccupancyMaxActiveBlocksPerMultiprocessor(&per_cu, (const void*)fwd_megakernel, NWAVES * 64, LDS_BYTES) != hipSuccess || per_cu < 1) { fprintf(stderr, "kernel_launch: occupancy query reports %d blocks per CU\n", per_cu); }
        (void)hipGetLastError();
        grid = cus;
        if (grid != 256) fprintf(stderr, "kernel_launch: %d CUs (built for 256)\n", grid);
    }
    if (grid < 0) return;
    (void)hipMemsetAsync((char*)d_ws + WS_CTL, 0, CTL_ZERO_BYTES, stream);
    Args a{};
    for (int i = 0; i < 10; ++i) a.in[i] = (const float*)d_in[i];
    a.out = (float*)d_out; a.ws = (unsigned char*)d_ws;
#if MK_MODE == 0
    a.ph_lo = 0; a.ph_hi = N_PHASES; a.li = 0;
    hipLaunchKernelGGL(fwd_megakernel, dim3(grid), dim3(NWAVES * 64), LDS_BYTES, stream, a);
#else
    unsigned char* ws = (unsigned char*)d_ws;
    for (int p = 0; p < N_PHASES; ++p) {
        a.ph_lo = p; a.ph_hi = p + 1; a.li = p;
        hipLaunchKernelGGL(fwd_megakernel, dim3(grid), dim3(NWAVES * 64), LDS_BYTES, stream, a);
        if (p == 2) {
            const bf16* QKV = (const bf16*)(ws + WS_QKV); const size_t TS = (size_t)M * DG;
            if (NAIVE_MOBA) hipLaunchKernelGGL(naive_moba, dim3(BATCH * NH * SEQ / 4), dim3(256), 0, stream, QKV, QKV + TS, QKV + 2 * TS, (const float*)(ws + WS_KMEAN), (bf16*)(ws + WS_O), (float*)(ws + WS_SSQA));
            if (NAIVE_SB) hipLaunchKernelGGL(naive_sb, dim3(BATCH * NH * SEQ / 4), dim3(256), 0, stream, QKV + 3 * TS, QKV + 4 * TS, QKV + 5 * TS, (bf16*)(ws + WS_O), (float*)(ws + WS_SSQB));
        }
    }
#endif
}
```

```cpp
#define MK_MODE 0
#define NAIVE_MOBA 0
#define NAIVE_SB 0
#include <hip/hip_runtime.h>
#include <cstdio>
#include <cstdint>
namespace pg8 {
#define PG8_LAS __attribute__((address_space(3)))
typedef unsigned short bf16_t;
typedef short bf16x8 __attribute__((ext_vector_type(8)));
typedef float f32x4 __attribute__((ext_vector_type(4)));
typedef unsigned u32x4 __attribute__((ext_vector_type(4)));
constexpr int BM = 256, BK = 64, HALF = 128, HTB = HALF * BK * 2  , STAGE_BYTES = 8 * HTB, NXCD = 8, WGM = 8;

__host__ __device__ __forceinline__ int lds_byte(int r, int c) { const int st = (r >> 4) * 2 + (c >> 5), rr = r & 15, cc = c & 31, ob = rr * 64 + cc * 2; return st * 1024 + (ob ^ (((ob >> 9) & 1) << 5)); }
__host__ __device__ __forceinline__ void stage_rc(int b, int& R, int& C) { const int st = b / 1024, sb = b % 1024, swz = sb ^ (((sb >> 9) & 1) << 5); R = (st >> 1) * 16 + swz / 64; C = (st & 1) * 32 + (swz % 64) / 2; }
__host__ __device__ __forceinline__ int perm32(int rho) { const int n = rho >> 4, i = rho & 15; return 8 * (i >> 2) + 4 * n + (i & 3); }

struct Unit { int pm, pn; };
struct Gemm { const bf16_t* A; const bf16_t* Bt; int M, N, K; };

struct StaticOrder {
    int nM, nN, nwg, G, c;
    __host__ __device__ void init(int M, int N, int G_, int c_) { nM = M / BM; nN = N / BM; nwg = nM * nN; G = G_; c = c_; }
    __host__ __device__ bool next(int i, Unit& u) const {
        const long L = (long)i * G + c; if (L >= nwg) return false;
        int wgid = (int)L; { const int q = nwg / NXCD, r = nwg % NXCD, xcd = wgid % NXCD, off = wgid / NXCD; wgid = (xcd < r ? xcd * (q + 1) : r * (q + 1) + (xcd - r) * q) + off; }
        const int nig = WGM * nN, gid = wgid / nig, fm = gid * WGM, gsz = (nM - fm) < WGM ? (nM - fm) : WGM;
        u.pm = fm + ((wgid % nig) % gsz); u.pn = (wgid % nig) / gsz; return true;
    }
    __device__ __forceinline__ void a_ready(const Unit&) const {}
    __device__ __forceinline__ void done(const Unit&) const {}
};


__device__ __forceinline__ unsigned cvt_pk_bf16(float lo, float hi) { unsigned r; asm volatile("v_cvt_pk_bf16_f32 %0, %1, %2" : "=v"(r) : "v"(lo), "v"(hi)); return r; }
__device__ __forceinline__ float xchg32(float v, bool upper) {
    auto r = __builtin_amdgcn_permlane32_swap(__float_as_uint(v), __float_as_uint(v), false, false);
    return __uint_as_float(upper ? r[0] : r[1]);
}
constexpr int P_M = 8192, P_SEQ = 2048, P_NH = 8, P_HD = 128, P_DG = 1024, P_DM = 2048, P_DFF = 8192;
constexpr float P_EPS = 1e-6f;
constexpr float P_C2 = 0.08838834764831845f * 1.4426950408889634f;

struct EpiQKV {
    static constexpr bool PERM = true, AFTER_DRAIN = false, HAS_MID = false;
    bf16_t* QKV; const float* r0; const float* rope; float* kmean;
    __device__ __forceinline__ void mid(f32x4 (&)[2][2][4][2], int, int) const {}
    __device__ __forceinline__ void operator()(const f32x4 (&acc)[2][2][4][2], const Unit& u, int wr, int wc, int fr, int fq) const {
        const int t = u.pn >> 2, hb = (u.pn & 3) * 2;
        const bool isq = (t == 0) || (t == 3), dorope = (t <= 1) && (wc == 0), iska = (t == 1);
        const float qs = isq ? P_C2 : 1.f;
        const int b = u.pm >> 3, blk = u.pm & 7;
        bf16_t* base = QKV + (size_t)t * ((size_t)P_M * P_DG) + ((size_t)(b * P_NH + hb) * P_SEQ) * P_HD + wc * 32 + fq * 8;
        const float sgn = (fq < 2) ? -1.f : 1.f; const int j0 = 8 * (fq & 1); const bool upper = fq >= 2;
        f32x4 ks[2][2];
#pragma unroll
        for (int bj = 0; bj < 2; ++bj)
#pragma unroll
            for (int n = 0; n < 2; ++n) ks[bj][n] = (f32x4){0.f, 0.f, 0.f, 0.f};
#pragma unroll
        for (int ai = 0; ai < 2; ++ai)
#pragma unroll
            for (int m = 0; m < 4; ++m) {
                const int rt = ai * HALF + wr * 64 + m * 16 + fr, s = blk * 256 + rt;
                const float rs = r0[u.pm * BM + rt] * qs;
                f32x4 c4[2], s4[2];
                if (dorope) { const float* rp = rope + s * 32 + j0; c4[0] = *(const f32x4*)rp; c4[1] = *(const f32x4*)(rp + 4); s4[0] = *(const f32x4*)(rp + 16) * sgn; s4[1] = *(const f32x4*)(rp + 20) * sgn; }
#pragma unroll
                for (int bj = 0; bj < 2; ++bj) {
                    f32x4 v[2] = {acc[ai][bj][m][0] * rs, acc[ai][bj][m][1] * rs};
                    if (dorope) {
#pragma unroll
                        for (int n = 0; n < 2; ++n)
#pragma unroll
                            for (int e = 0; e < 4; ++e) { const float o = xchg32(v[n][e], upper); v[n][e] = v[n][e] * c4[n][e] + o * s4[n][e]; }
                    }
                    if (iska) { ks[bj][0] += v[0]; ks[bj][1] += v[1]; }
                    u32x4 w; w.x = cvt_pk_bf16(v[0][0], v[0][1]); w.y = cvt_pk_bf16(v[0][2], v[0][3]); w.z = cvt_pk_bf16(v[1][0], v[1][1]); w.w = cvt_pk_bf16(v[1][2], v[1][3]);
                    *(u32x4*)(base + ((size_t)bj * P_SEQ + s) * P_HD) = w;
                }
            }
        if (iska && kmean) {
#pragma unroll
            for (int bj = 0; bj < 2; ++bj)
#pragma unroll
                for (int n = 0; n < 2; ++n)
#pragma unroll
                    for (int e = 0; e < 4; ++e) { float x = ks[bj][n][e]; x += __shfl_xor(x, 1); x += __shfl_xor(x, 2); x += __shfl_xor(x, 4); x += __shfl_xor(x, 8);
                        if (fr == 0) atomicAdd(kmean + ((size_t)((b * P_NH + hb + bj) * 8 + blk)) * P_HD + wc * 32 + fq * 8 + n * 4 + e, x * (1.0f / 256.0f)); }
        }
    }
};

struct EpiUp {
    static constexpr bool PERM = true, AFTER_DRAIN = false, HAS_MID = false;
    bf16_t* O; const float* ssq;
    __device__ __forceinline__ void mid(f32x4 (&)[2][2][4][2], int, int) const {}
    __device__ __forceinline__ void operator()(const f32x4 (&acc)[2][2][4][2], const Unit& u, int wr, int wc, int fr, int fq) const {
#pragma unroll
        for (int ai = 0; ai < 2; ++ai)
#pragma unroll
            for (int m = 0; m < 4; ++m) {
                const int row = u.pm * BM + ai * HALF + wr * 64 + m * 16 + fr;
                float sq = 0.f;
#pragma unroll
                for (int p = 0; p < 8; ++p) sq += ssq[(size_t)p * P_M + row];
                const float r = 1.0f / sqrtf(sq * (1.0f / P_DM) + P_EPS);
                bf16_t* rowp = O + (size_t)row * P_DFF + u.pn * BM + wc * 32 + fq * 8;
#pragma unroll
                for (int bj = 0; bj < 2; ++bj) {
                    f32x4 v0 = acc[ai][bj][m][0] * r, v1 = acc[ai][bj][m][1] * r;
#pragma unroll
                    for (int e = 0; e < 4; ++e) { const float a = fmaxf(v0[e], 0.f), c = fmaxf(v1[e], 0.f); v0[e] = a * a; v1[e] = c * c; }
                    u32x4 w; w.x = cvt_pk_bf16(v0[0], v0[1]); w.y = cvt_pk_bf16(v0[2], v0[3]); w.z = cvt_pk_bf16(v1[0], v1[1]); w.w = cvt_pk_bf16(v1[2], v1[3]);
                    *(u32x4*)(rowp + bj * HALF) = w;
                }
            }
    }
};

__device__ __forceinline__ void row_ssq_publish(const float (&ss)[2][4], const Unit& u, int wr, int wc, int fr, int fq, PG8_LAS float* P  , float* dst  ) {
#pragma unroll
    for (int ai = 0; ai < 2; ++ai)
#pragma unroll
        for (int m = 0; m < 4; ++m) { float s = ss[ai][m]; s += __shfl_xor(s, 16); s += __shfl_xor(s, 32);
            if (fq == 0) P[(ai * HALF + wr * 64 + m * 16 + fr) * 4 + wc] = s; }
    asm volatile("s_waitcnt lgkmcnt(0)" ::: "memory"); __builtin_amdgcn_s_barrier(); asm volatile("" ::: "memory");
    const int tid = threadIdx.x;
    if (tid < 256) { const float s = (P[tid * 4 + 0] + P[tid * 4 + 1]) + (P[tid * 4 + 2] + P[tid * 4 + 3]); dst[(size_t)u.pn * P_M + u.pm * BM + tid] = s; }
}

struct EpiOut {
    static constexpr bool PERM = false, AFTER_DRAIN = true, HAS_MID = true;
    const float* x; float* x1; bf16_t* x1b; float* ssq1; PG8_LAS const float* tab  ; PG8_LAS float* P;
    __device__ __forceinline__ void mid(f32x4 (&acc)[2][2][4][2], int wr, int fr) const {
#pragma unroll
        for (int ai = 0; ai < 2; ++ai)
#pragma unroll
            for (int m = 0; m < 4; ++m) { const float f = tab[(ai * HALF + wr * 64 + m * 16 + fr) * 2];
#pragma unroll
                for (int bj = 0; bj < 2; ++bj)
#pragma unroll
                    for (int n = 0; n < 2; ++n) acc[ai][bj][m][n] *= f; }
    }
    __device__ __forceinline__ void fused(f32x4 (&acc)[2][2][4][2], const Unit& u, int wr, int wc, int fr, int fq, PG8_LAS unsigned char*, int, int) const {
        typedef unsigned u32x2v __attribute__((ext_vector_type(2)));
        const int col0 = u.pn * BM + wc * 32 + 4 * fq; float ss[2][4];
#pragma unroll
        for (int ai = 0; ai < 2; ++ai)
#pragma unroll
            for (int m = 0; m < 4; ++m) { const int r = ai * HALF + wr * 64 + m * 16 + fr; const float rb = tab[r * 2 + 1]; const size_t off = (size_t)(u.pm * BM + r) * P_DM + col0; float s = 0.f;
#pragma unroll
                for (int bj = 0; bj < 2; ++bj)
#pragma unroll
                    for (int n = 0; n < 2; ++n) { const f32x4 xin = *(const f32x4*)(x + off + bj * HALF + n * 16); const f32x4 o = xin + acc[ai][bj][m][n] * rb;
                        *(f32x4*)(x1 + off + bj * HALF + n * 16) = o; u32x2v w; w.x = cvt_pk_bf16(o[0], o[1]); w.y = cvt_pk_bf16(o[2], o[3]); *(u32x2v*)(x1b + off + bj * HALF + n * 16) = w;
                        s += (o[0] * o[0] + o[1] * o[1]) + (o[2] * o[2] + o[3] * o[3]); }
                ss[ai][m] = s; }
        row_ssq_publish(ss, u, wr, wc, fr, fq, P, ssq1);
    }
};

struct EpiDown {
    static constexpr bool PERM = false, AFTER_DRAIN = true, HAS_MID = false;
    float* xio; float* ssq2; PG8_LAS float* P;
    __device__ __forceinline__ void mid(f32x4 (&)[2][2][4][2], int, int) const {}
    __device__ __forceinline__ void fused(f32x4 (&acc)[2][2][4][2], const Unit& u, int wr, int wc, int fr, int fq, PG8_LAS unsigned char*, int, int) const {
        const int col0 = u.pn * BM + wc * 32 + 4 * fq; float ss[2][4];
#pragma unroll
        for (int ai = 0; ai < 2; ++ai)
#pragma unroll
            for (int m = 0; m < 4; ++m) { const int r = ai * HALF + wr * 64 + m * 16 + fr; const size_t off = (size_t)(u.pm * BM + r) * P_DM + col0; float s = 0.f;
#pragma unroll
                for (int bj = 0; bj < 2; ++bj)
#pragma unroll
                    for (int n = 0; n < 2; ++n) { const f32x4 o = *(const f32x4*)(xio + off + bj * HALF + n * 16) + acc[ai][bj][m][n];
                        *(f32x4*)(xio + off + bj * HALF + n * 16) = o; s += (o[0] * o[0] + o[1] * o[1]) + (o[2] * o[2] + o[3] * o[3]); }
                ss[ai][m] = s; }
        row_ssq_publish(ss, u, wr, wc, fr, fq, P, ssq2);
    }
};

template <class Epi, class Sched, bool ALIGN_EPI = false, bool SP2 = false>
__device__ __forceinline__ void gemm_phase(PG8_LAS unsigned char* lds, const Gemm g, const Sched& S, const Epi& E) {
    int tid_ = threadIdx.x; asm volatile("" : "+v"(tid_));
    const int tid = tid_, wid = __builtin_amdgcn_readfirstlane(tid >> 6), lane = tid & 63, wr = wid >> 2, wc = wid & 3, fr = lane & 15, fq = lane >> 4;
    const int K = g.K, nt = K / BK;
    unsigned voffA[2], voffB[2];
#pragma unroll
    for (int i = 0; i < 2; ++i) { int R, C; stage_rc(tid * 16 + i * 8192, R, C); const int Rb = Epi::PERM ? ((R & ~31) + perm32(R & 31)) : R;
        voffA[i] = (unsigned)(R * K + C) * 2u; voffB[i] = (unsigned)(Rb * K + C) * 2u; }
    const size_t kstep = (size_t)(BK * 2);
    const size_t hstep = (size_t)HALF * K * 2;
    const size_t tstep = 2 * hstep;
    const unsigned ldsw = (unsigned)wid * 1024u;
    const int aoff = lds_byte(wr * 64 + fr, fq * 8), boff = lds_byte(wc * 32 + fr, fq * 8);
#define PG8_SA(b, h) (((b) * 2 + (h)) * HTB)
#define PG8_SB(b, h) ((4 + (b) * 2 + (h)) * HTB)
#define PG8_STAGE(bufoff, gbase, voff) do { _Pragma("unroll") for (int _i = 0; _i < 2; ++_i) \
        __builtin_amdgcn_global_load_lds((const unsigned*)((const char*)(gbase) + (voff)[_i]), (PG8_LAS unsigned*)(lds + (bufoff) + ldsw + _i * 8192), 16, 0, 0); } while (0)
#define PG8_LDA(dst, b, h) do { _Pragma("unroll") for (int m = 0; m < 4; ++m) _Pragma("unroll") for (int k = 0; k < 2; ++k) dst[m][k] = *(const PG8_LAS bf16x8*)(lds + PG8_SA(b, h) + aoff + m * 2048 + k * 1024); } while (0)
#define PG8_LDB(dst, b, h) do { _Pragma("unroll") for (int n = 0; n < 2; ++n) _Pragma("unroll") for (int k = 0; k < 2; ++k) dst[n][k] = *(const PG8_LAS bf16x8*)(lds + PG8_SB(b, h) + boff + n * 2048 + k * 1024); } while (0)
#define PG8_MMA(ai, bj, At, Bt) do { __builtin_amdgcn_s_setprio(1); _Pragma("unroll") for (int m = 0; m < 4; ++m) _Pragma("unroll") for (int n = 0; n < 2; ++n) _Pragma("unroll") for (int k = 0; k < 2; ++k) \
        acc[ai][bj][m][n] = __builtin_amdgcn_mfma_f32_16x16x32_bf16(Bt[n][k], At[m][k], acc[ai][bj][m][n], 0, 0, 0); __builtin_amdgcn_s_setprio(0); } while (0)
#define PG8_WAIT_V(n) asm volatile("s_waitcnt vmcnt(" #n ")" ::: "memory")
#define PG8_WAIT_L(n) asm volatile("s_waitcnt lgkmcnt(" #n ")" ::: "memory")
#define PG8_BAR __builtin_amdgcn_s_barrier()
#define PG8_SCHED __builtin_amdgcn_sched_barrier(0)
    Unit cur, nxt; int ui = 0;
    if (!S.next(0, cur)) return;
    f32x4 acc[2][2][4][2];
#pragma unroll
    for (int a = 0; a < 2; ++a)
#pragma unroll
        for (int b = 0; b < 2; ++b)
#pragma unroll
            for (int m = 0; m < 4; ++m)
#pragma unroll
                for (int n = 0; n < 2; ++n) acc[a][b][m][n] = (f32x4){0.f, 0.f, 0.f, 0.f};
    bf16x8 At[4][2], B0[2][2], B1[2][2];
    const char* cA = (const char*)g.A + (size_t)cur.pm * tstep; const char* cB = (const char*)g.Bt + (size_t)cur.pn * tstep;
    S.a_ready(cur);
    if constexpr (SP2) {
        PG8_STAGE(PG8_SB(0, 0), cB, voffB); PG8_STAGE(PG8_SB(0, 1), cB + hstep, voffB); PG8_STAGE(PG8_SA(0, 0), cA, voffA); PG8_STAGE(PG8_SA(0, 1), cA + hstep, voffA);
        if (wr == 1) PG8_BAR;
        PG8_WAIT_V(2); PG8_BAR;
        PG8_STAGE(PG8_SB(1, 0), cB + kstep, voffB); PG8_STAGE(PG8_SA(1, 0), cA + kstep, voffA); PG8_STAGE(PG8_SB(1, 1), cB + hstep + kstep, voffB);
        PG8_WAIT_V(6); PG8_BAR;
    } else {
        PG8_STAGE(PG8_SB(0, 0), cB, voffB); PG8_STAGE(PG8_SA(0, 0), cA, voffA); PG8_STAGE(PG8_SB(0, 1), cB + hstep, voffB); PG8_STAGE(PG8_SA(0, 1), cA + hstep, voffA);
        if (wr == 1) PG8_BAR;
        PG8_WAIT_V(4); PG8_BAR;
        PG8_STAGE(PG8_SB(1, 0), cB + kstep, voffB); PG8_STAGE(PG8_SA(1, 0), cA + kstep, voffA); PG8_STAGE(PG8_SB(1, 1), cB + hstep + kstep, voffB);
        PG8_WAIT_V(6); PG8_BAR;
    }
    for (;;) {
        const bool has_next = S.next(ui + 1, nxt);
        const char* nA = has_next ? (const char*)g.A + (size_t)nxt.pm * tstep : cA; const char* nB = has_next ? (const char*)g.Bt + (size_t)nxt.pn * tstep : cB;
        for (int t = 0; t < nt; t += 2) {
            const bool last = (t == nt - 2);
            const char* a1 = cA + (size_t)(t + 1) * kstep;
            const char* a2 = last ? nA : cA + (size_t)(t + 2) * kstep; const char* b2 = last ? nB : cB + (size_t)(t + 2) * kstep;
            const char* a3 = a2 + kstep; const char* b3 = b2 + kstep;
            if (last && has_next) S.a_ready(nxt);
            if constexpr (SP2) {
            PG8_LDB(B0, 0, 0); PG8_LDB(B1, 0, 1); PG8_SCHED; PG8_LDA(At, 0, 0); PG8_STAGE(PG8_SA(1, 1), a1 + hstep, voffA);
            PG8_WAIT_V(8); PG8_WAIT_L(0); PG8_BAR; PG8_MMA(0, 0, At, B0); PG8_MMA(0, 1, At, B1); PG8_BAR; PG8_SCHED;
            PG8_LDA(At, 0, 1); PG8_STAGE(PG8_SB(0, 0), b2, voffB); PG8_STAGE(PG8_SB(0, 1), b2 + hstep, voffB); PG8_STAGE(PG8_SA(0, 0), a2, voffA);
            PG8_WAIT_V(8); PG8_WAIT_L(0); PG8_BAR; PG8_MMA(1, 0, At, B0); PG8_MMA(1, 1, At, B1); PG8_BAR; PG8_SCHED;
            PG8_LDB(B0, 1, 0); PG8_LDB(B1, 1, 1); PG8_SCHED; PG8_LDA(At, 1, 0); PG8_STAGE(PG8_SA(0, 1), a2 + hstep, voffA);
            PG8_WAIT_V(8); PG8_WAIT_L(0); PG8_BAR; PG8_MMA(0, 0, At, B0); PG8_MMA(0, 1, At, B1); PG8_BAR; PG8_SCHED;
            PG8_LDA(At, 1, 1); PG8_STAGE(PG8_SB(1, 0), b3, voffB); PG8_STAGE(PG8_SB(1, 1), b3 + hstep, voffB); PG8_STAGE(PG8_SA(1, 0), a3, voffA);
            PG8_WAIT_V(8); PG8_WAIT_L(0); PG8_BAR; PG8_MMA(1, 0, At, B0); PG8_MMA(1, 1, At, B1); PG8_BAR; PG8_SCHED;
            } else {
            PG8_LDB(B0, 0, 0); PG8_SCHED; PG8_LDA(At, 0, 0); PG8_STAGE(PG8_SA(1, 1), a1 + hstep, voffA);
            PG8_WAIT_L(8); PG8_BAR; PG8_WAIT_L(0); PG8_MMA(0, 0, At, B0); PG8_BAR; PG8_SCHED;
            PG8_LDB(B1, 0, 1); PG8_STAGE(PG8_SB(0, 0), b2, voffB);
            PG8_BAR; PG8_WAIT_L(0); PG8_MMA(0, 1, At, B1); PG8_BAR;
            PG8_LDA(At, 0, 1); PG8_STAGE(PG8_SA(0, 0), a2, voffA);
            PG8_BAR; PG8_WAIT_L(0); PG8_MMA(1, 0, At, B0); PG8_BAR; PG8_SCHED;
            PG8_STAGE(PG8_SB(0, 1), b2 + hstep, voffB);
            PG8_WAIT_V(6); PG8_BAR; PG8_MMA(1, 1, At, B1); PG8_BAR;
            PG8_LDB(B0, 1, 0); PG8_SCHED; PG8_LDA(At, 1, 0); PG8_STAGE(PG8_SA(0, 1), a2 + hstep, voffA);
            PG8_WAIT_L(8); PG8_BAR; PG8_WAIT_L(0); PG8_MMA(0, 0, At, B0); PG8_BAR; PG8_SCHED;
            PG8_LDB(B1, 1, 1); PG8_STAGE(PG8_SB(1, 0), b3, voffB);
            PG8_BAR; PG8_WAIT_L(0); PG8_MMA(0, 1, At, B1); PG8_BAR;
            PG8_LDA(At, 1, 1); PG8_STAGE(PG8_SA(1, 0), a3, voffA);
            PG8_BAR; PG8_WAIT_L(0); PG8_MMA(1, 0, At, B0); PG8_BAR; PG8_SCHED;
            PG8_STAGE(PG8_SB(1, 1), b3 + hstep, voffB);
            PG8_WAIT_V(6); PG8_BAR; PG8_MMA(1, 1, At, B1); PG8_BAR;
            }
            if constexpr (Epi::HAS_MID) { if (t == nt / 2 - 2) E.mid(acc, wr, fr); }
        }
        if constexpr (ALIGN_EPI) { if (wr == 0) PG8_BAR; }
        if constexpr (!Epi::AFTER_DRAIN) { E(acc, cur, wr, wc, fr, fq); S.done(cur); }
        if (!has_next) break;
#pragma unroll
        for (int a = 0; a < 2; ++a)
#pragma unroll
            for (int b = 0; b < 2; ++b)
#pragma unroll
                for (int m = 0; m < 4; ++m)
#pragma unroll
                    for (int n = 0; n < 2; ++n) acc[a][b][m][n] = (f32x4){0.f, 0.f, 0.f, 0.f};
        cur = nxt; cA = nA; cB = nB; ++ui;
        if constexpr (ALIGN_EPI) { if (wr == 1) PG8_BAR; }
    }
    PG8_WAIT_V(0);
    if constexpr (!ALIGN_EPI) { if (wr == 0) PG8_BAR; }
    PG8_BAR;
    if constexpr (Epi::AFTER_DRAIN) { E.fused(acc, cur, wr, wc, fr, fq, lds, wid, lane); S.done(cur); }
#undef PG8_SA
#undef PG8_SB
#undef PG8_STAGE
#undef PG8_LDA
#undef PG8_LDB
#undef PG8_MMA
#undef PG8_WAIT_V
#undef PG8_WAIT_L
#undef PG8_BAR
#undef PG8_SCHED
}
}


constexpr int NWAVES = 8;
#ifndef MK_MODE
#define MK_MODE 0
#endif
#ifndef NAIVE_MOBA
#define NAIVE_MOBA 0
#endif
#ifndef DUP_PHASE
#define DUP_PHASE -1
#endif
#define REPS(k) for (int rep_ = 0; rep_ < ((DUP_PHASE == (k)) ? 2 : 1); ++rep_)
#ifndef NAIVE_SB
#define NAIVE_SB 0
#endif
constexpr int N_PHASES = 7;

constexpr int BATCH = 4, SEQ = 2048, DM = 2048, NH = 8, HD = 128, DG = 1024, DQKV = 6144, DFF = 8192, M = BATCH * SEQ;
constexpr float EPS = 1e-6f;
constexpr float C2 = pg8::P_C2;

constexpr size_t MiB = 1u << 20;
constexpr size_t WS_CTL = 0, CTL_ZERO_BYTES = 256 * 1024;
constexpr size_t WS_KMEAN = 128 * 1024;
constexpr size_t WS_R0 = 256 * 1024;
constexpr size_t WS_ROPE = 320 * 1024;
constexpr size_t WS_SSQA = 576 * 1024;
constexpr size_t WS_SSQB = 832 * 1024;
constexpr size_t WS_SSQ1 = 1088 * 1024;
constexpr size_t WS_SSQ2 = 1344 * 1024;
constexpr size_t WS_WOUT = 2 * MiB, WS_WUP = 10 * MiB, WS_WDOWN = 42 * MiB;
constexpr size_t WS_X1B = 74 * MiB;
constexpr size_t WS_R = 106 * MiB;
constexpr size_t WS_WIN = WS_R, WS_O = WS_R, WS_QKV = WS_R + 32 * MiB, WS_ACT = WS_R, WS_END = 234 * MiB;
static_assert(WS_QKV + (size_t)6 * M * DG * 2 == WS_END && WS_ACT + (size_t)M * DFF * 2 == WS_END && WS_SSQ2 + 8 * M * 4 <= WS_WOUT, "d_ws map");
constexpr int CW_BAR = 1024;

constexpr int RING_OFF = 0, RING_BYTES = 131072;
constexpr int TAB_OFF = RING_BYTES;
constexpr int PST_OFF = TAB_OFF + 2048;
constexpr int LDSCTL_OFF = PST_OFF + 4096, MISC_OFF = LDSCTL_OFF + 320;
constexpr int LDS_BYTES = 147456;
static_assert(MISC_OFF + 128 <= LDS_BYTES, "LDS map");

#define GAS __attribute__((address_space(1)))
#define LAS __attribute__((address_space(3)))
typedef unsigned short bf16;
typedef unsigned v4u __attribute__((ext_vector_type(4)));
typedef float f32x4 __attribute__((ext_vector_type(4)));
typedef short bf16x8 __attribute__((ext_vector_type(8)));
typedef GAS unsigned gu32;
typedef GAS unsigned long long gu64;
#define RLX_AGENT __ATOMIC_RELAXED, __HIP_MEMORY_SCOPE_AGENT
#define LDS_WAIT() asm volatile("s_waitcnt lgkmcnt(0)" ::: "memory")
#define VM_WAIT() asm volatile("s_waitcnt vmcnt(0)" ::: "memory")
__device__ __forceinline__ unsigned long long rt() { return __builtin_amdgcn_s_memrealtime(); }
__device__ __forceinline__ unsigned f2bf(float f) { unsigned u = __builtin_bit_cast(unsigned, f); return (u + 0x7fffu + ((u >> 16) & 1u)) >> 16; }
__device__ __forceinline__ unsigned pk2(float lo, float hi) { return f2bf(lo) | (f2bf(hi) << 16); }

#define XB_TMO      128
#define XB_XCNT(j)  (256  + 64 * (j))
#define XB_XSUB(j)  (1280 + 64 * (j))
#define XB_XGEN(j)  (2304 + 64 * (j))
#define XB_TOP      3328
#define XB_TOPGEN   3392
#define XCD_BAR_WORDS 3456
#define XB_SPIN_CAP (1u << 18)

__device__ __forceinline__ unsigned xb_ld(unsigned* p)              { return __hip_atomic_load(p, __ATOMIC_RELAXED, __HIP_MEMORY_SCOPE_AGENT); }
__device__ __forceinline__ unsigned xb_add(unsigned* p, unsigned v) { return __hip_atomic_fetch_add(p, v, __ATOMIC_RELAXED, __HIP_MEMORY_SCOPE_AGENT); }
__device__ __forceinline__ unsigned xb_xcc_id() { return (unsigned)__builtin_amdgcn_s_getreg((3 << 11) | 20) & 0xFu; }
#define XB_SPIN(cond, bar) do { unsigned _sp = 0; while (cond) { __builtin_amdgcn_s_sleep(1); \
    if ((++_sp & 255u) == 0u) { if (xb_ld(&(bar)[XB_TMO])) break; if (_sp > XB_SPIN_CAP) { atomicAdd(&(bar)[XB_TMO], 1u); break; } } } } while (0)

struct XcdBarrier {
    unsigned* bar; unsigned x;
    volatile LAS unsigned* st;
};

__device__ __forceinline__ XcdBarrier xcd_barrier_post(unsigned* bar, volatile LAS unsigned* st) {
    XcdBarrier b; b.bar = bar; b.x = xb_xcc_id(); b.st = st;
    if (threadIdx.x == 0) (void)xb_add(&bar[XB_XCNT(b.x)], 1u);
    return b;
}
__device__ __forceinline__ void xcd_barrier_complete(unsigned* bar, unsigned x, unsigned& nloc, unsigned& nx) {
    const unsigned G = gridDim.x * gridDim.y * gridDim.z;
    unsigned sum, cnt, mine, sp = 0u;
    for (;;) {
        sum = 0u; cnt = 0u; mine = 0u;
#pragma unroll
        for (unsigned j = 0; j < 16; ++j) { const unsigned c = xb_ld(&bar[XB_XCNT(j)]); sum += c; cnt += (c > 0u) ? 1u : 0u; mine = (j == x) ? c : mine; }
        if (sum == G) break;
        __builtin_amdgcn_s_sleep(1);
        if ((++sp & 255u) == 0u) { if (xb_ld(&bar[XB_TMO])) break; if (sp > XB_SPIN_CAP) { atomicAdd(&bar[XB_TMO], 1u); break; } }
    }
    nloc = mine > 0u ? mine : 1u; nx = cnt > 0u ? cnt : 1u;
}

__device__ __forceinline__ void xcd_barrier(const XcdBarrier& b) {
    asm volatile("s_waitcnt vmcnt(0)" ::: "memory");
    __syncthreads();
    if (threadIdx.x == 0) {
        unsigned* bar = b.bar;
        __builtin_amdgcn_s_waitcnt(0);
        unsigned nloc = b.st[0], nx = b.st[1];
        if (nloc == 0u) { xcd_barrier_complete(bar, b.x, nloc, nx); b.st[0] = nloc; b.st[1] = nx; }
        const unsigned old = xb_add(&bar[XB_XSUB(b.x)], 1u);
        const unsigned gen = old / nloc;
        if (old + 1u == (gen + 1u) * nloc) {
            __builtin_amdgcn_fence(__ATOMIC_RELEASE, "agent");
            asm volatile("s_waitcnt vmcnt(0)" ::: "memory");
            const unsigned og = xb_add(&bar[XB_TOP], 1u);
            const unsigned tg = og / nx;
            if (og + 1u == (tg + 1u) * nx) xb_add(&bar[XB_TOPGEN], 1u);
            else XB_SPIN(xb_ld(&bar[XB_TOPGEN]) == tg, bar);
            __builtin_amdgcn_fence(__ATOMIC_ACQUIRE, "agent");
            xb_add(&bar[XB_XGEN(b.x)], 1u);
            asm volatile("s_waitcnt vmcnt(0)" ::: "memory");
        } else {
            XB_SPIN(xb_ld(&bar[XB_XGEN(b.x)]) == gen, bar);
            __builtin_amdgcn_fence(__ATOMIC_ACQUIRE, "agent");
            asm volatile("s_waitcnt vmcnt(0)" ::: "memory");
        }
    }
    __syncthreads();
}


struct Frame {
    LAS unsigned char* lds;
    volatile LAS unsigned* MISC;
    gu32* ctl;
    int vcu, G;
};

__device__ __forceinline__ float wave_sum(float v) {
#pragma unroll
    for (int o = 1; o < 64; o <<= 1) v += __shfl_xor(v, o);
    return v;
}
__device__ __forceinline__ float wave_max(float v) {
#pragma unroll
    for (int o = 1; o < 64; o <<= 1) v = fmaxf(v, __shfl_xor(v, o));
    return v;
}
__device__ __forceinline__ float bf2f(unsigned short h) { return __uint_as_float((unsigned)h << 16); }

__device__ __forceinline__ void p0_transpose_item(const float* W, const float* g, int K, int N, bf16* WT, LAS float* scr, int item, int lane) {
    const int nblk = N / 32, kb = item / nblk, nb = item % nblk, k0 = 64 * kb, n0 = 32 * nb;
#pragma unroll
    for (int i = 0; i < 32; ++i) { const int kk = 2 * i + (lane >> 5); const float gv = g ? g[k0 + kk] : 1.f; scr[kk * 33 + (lane & 31)] = W[(size_t)(k0 + kk) * N + n0 + (lane & 31)] * gv; }
    LDS_WAIT(); asm volatile("" ::: "memory");
    const int c = lane & 7;
#pragma unroll
    for (int j = 0; j < 4; ++j) { const int n = (lane >> 3) + 8 * j; const LAS float* s = scr + (8 * c) * 33 + n;
        v4u o; o.x = pk2(s[0 * 33], s[1 * 33]); o.y = pk2(s[2 * 33], s[3 * 33]); o.z = pk2(s[4 * 33], s[5 * 33]); o.w = pk2(s[6 * 33], s[7 * 33]);
        *(GAS v4u*)(WT + (size_t)(n0 + n) * K + k0 + 8 * c) = o; }
    LDS_WAIT(); asm volatile("" ::: "memory");
}

struct Args { const float* in[10]; float* out; unsigned char* ws; int ph_lo, ph_hi, li, pad; };

__global__ void __launch_bounds__(256) naive_moba(const bf16* __restrict__ Q, const bf16* __restrict__ K, const bf16* __restrict__ V, const float* __restrict__ kmean, bf16* O, float* ssq) {
    __shared__ float qs[4][128];
    const int tid = threadIdx.x, lane = tid & 63, w = tid >> 6; const int gw = blockIdx.x * 4 + w;
    const int bh = gw / SEQ, t = gw % SEQ, b = bh / NH, h = bh % NH, blk_i = t >> 8;
    const bf16* qrow = Q + ((size_t)bh * SEQ + t) * HD;
    const float q0 = bf2f(qrow[2 * lane]), q1 = bf2f(qrow[2 * lane + 1]);
    qs[w][2 * lane] = q0; qs[w][2 * lane + 1] = q1;
    __syncthreads();
    float gate[8];
#pragma unroll
    for (int j = 0; j < 8; ++j) { const float* km = kmean + ((size_t)bh * 8 + j) * HD; gate[j] = wave_sum(q0 * km[2 * lane] + q1 * km[2 * lane + 1]); }
    unsigned sel = 0;
#pragma unroll
    for (int j = 0; j < 8; ++j) { int rank = 0;
#pragma unroll
        for (int jj = 0; jj < 8; ++jj) if (jj < blk_i && (gate[jj] > gate[j] || (gate[jj] == gate[j] && jj < j))) ++rank;
        if (j < blk_i && rank < 3) sel |= 1u << j; }
    sel |= 1u << blk_i;
    float m = -1e30f, l = 0.f, o0 = 0.f, o1 = 0.f;
    for (int j = 0; j <= blk_i; ++j) {
        if (!((sel >> j) & 1u)) continue;
        for (int c = 0; c < 4; ++c) {
            const int key = j * 256 + c * 64 + lane; const bf16* krow = K + ((size_t)bh * SEQ + key) * HD;
            float s = 0.f;
            for (int d = 0; d < 128; d += 8) { const v4u kk = *(const v4u*)(krow + d);
                s += qs[w][d] * __uint_as_float(kk.x << 16) + qs[w][d + 1] * __uint_as_float(kk.x & 0xffff0000u) + qs[w][d + 2] * __uint_as_float(kk.y << 16) + qs[w][d + 3] * __uint_as_float(kk.y & 0xffff0000u)
                   + qs[w][d + 4] * __uint_as_float(kk.z << 16) + qs[w][d + 5] * __uint_as_float(kk.z & 0xffff0000u) + qs[w][d + 6] * __uint_as_float(kk.w << 16) + qs[w][d + 7] * __uint_as_float(kk.w & 0xffff0000u); }
            if (key > t) s = -__builtin_inff();
            const float cm = wave_max(s), mn = fmaxf(m, cm), alpha = exp2f(m - mn), p = exp2f(s - mn);
            l = l * alpha + wave_sum(p); o0 *= alpha; o1 *= alpha; m = mn;
            for (int kk = 0; kk < 64; ++kk) { const float pk = __shfl(p, kk); const bf16* vrow = V + ((size_t)bh * SEQ + j * 256 + c * 64 + kk) * HD;
                const unsigned vv = *(const unsigned*)(vrow + 2 * lane); o0 += pk * __uint_as_float(vv << 16); o1 += pk * __uint_as_float(vv & 0xffff0000u); }
        }
    }
    o0 /= l; o1 /= l;
    *(unsigned*)(O + ((size_t)b * SEQ + t) * DM + h * HD + 2 * lane) = pk2(o0, o1);
    const float ss = wave_sum(o0 * o0 + o1 * o1);
    if (lane == 0) ssq[(size_t)h * M + b * SEQ + t] = ss;
}
__global__ void __launch_bounds__(256) naive_sb(const bf16* __restrict__ Q, const bf16* __restrict__ K, const bf16* __restrict__ V, bf16* O, float* ssq) {
    __shared__ float qs[4][128];
    const int tid = threadIdx.x, lane = tid & 63, w = tid >> 6; const int gw = blockIdx.x * 4 + w;
    const int bh = gw / SEQ, t = gw % SEQ, b = bh / NH, h = bh % NH;
    const bf16* qrow = Q + ((size_t)bh * SEQ + t) * HD;
    qs[w][2 * lane] = bf2f(qrow[2 * lane]); qs[w][2 * lane + 1] = bf2f(qrow[2 * lane + 1]);
    __syncthreads();
    float R = 0.f, o0 = 0.f, o1 = 0.f;
    for (int hi = t - 1; hi >= 0; hi -= 64) {
        const int key = hi - lane; const bool valid = key >= 0; const int kc = valid ? key : 0;
        const bf16* krow = K + ((size_t)bh * SEQ + kc) * HD;
        float s = 0.f;
        for (int d = 0; d < 128; d += 8) { const v4u kk = *(const v4u*)(krow + d);
            s += qs[w][d] * __uint_as_float(kk.x << 16) + qs[w][d + 1] * __uint_as_float(kk.x & 0xffff0000u) + qs[w][d + 2] * __uint_as_float(kk.y << 16) + qs[w][d + 3] * __uint_as_float(kk.y & 0xffff0000u)
               + qs[w][d + 4] * __uint_as_float(kk.z << 16) + qs[w][d + 5] * __uint_as_float(kk.z & 0xffff0000u) + qs[w][d + 6] * __uint_as_float(kk.w << 16) + qs[w][d + 7] * __uint_as_float(kk.w & 0xffff0000u); }
        float l2 = valid ? -(fmaxf(s, 0.f) + log2f(1.0f + exp2f(-fabsf(s)))) : 0.f;
        float pre = l2;
#pragma unroll
        for (int o = 1; o < 64; o <<= 1) { const float up = __shfl_up(pre, o); if (lane >= o) pre += up; }
        const float a = valid ? exp2f(s + R + pre) : 0.f;
        R += __shfl(pre, 63);
        for (int kk = 0; kk < 64; ++kk) { if (hi - kk < 0) break; const float ak = __shfl(a, kk); const bf16* vrow = V + ((size_t)bh * SEQ + hi - kk) * HD;
            const unsigned vv = *(const unsigned*)(vrow + 2 * lane); o0 += ak * __uint_as_float(vv << 16); o1 += ak * __uint_as_float(vv & 0xffff0000u); }
    }
    *(unsigned*)(O + ((size_t)b * SEQ + t) * DM + DG + h * HD + 2 * lane) = pk2(o0, o1);
    const float ss = wave_sum(o0 * o0 + o1 * o1);
    if (lane == 0) ssq[(size_t)h * M + b * SEQ + t] = ss;
}

namespace att {
typedef short bf16x8 __attribute__((ext_vector_type(8)));
typedef short s16x4 __attribute__((ext_vector_type(4)));
typedef float f32x16 __attribute__((ext_vector_type(16)));
typedef unsigned u32x4 __attribute__((ext_vector_type(4)));
constexpr int QBLK = 32, KVBLK = 64, QB = 256, D = 128;
constexpr int SHM_V = KVBLK * D * 2, SHM_K = KVBLK * D * 2;
constexpr int A_V = 0, A_K = 2 * SHM_V, A_WS = 2 * SHM_V + 2 * SHM_K, A_KM = A_WS + 8 * 64 * 4, A_END = A_KM + 8 * 128 * 4;
static_assert(A_END <= RING_BYTES, "attention LDS inside the ring region");
#define KSWZ(row, colB) ((row) * 256 + ((colB) ^ (((row) & 7) << 4)))
#define SBAR() __builtin_amdgcn_sched_barrier(0)
__device__ __forceinline__ int v_st(int k, int c) { const int kk = (k & ~0xC) | ((k & 4) << 1) | ((k & 8) >> 1); return ((kk >> 3) * 4 + (c >> 5)) * 512 + ((kk & 7) * 32 + (c & 31)) * 2; }
__device__ __forceinline__ int v_rd_base(int lane) { return ((lane & 3) << 3) | (((lane >> 2) & 3) << 6) | (((lane >> 4) & 1) << 5) | (((lane >> 5) & 1) << 8); }
constexpr int v_rd_off(int d0, int ks, int half) { return d0 * 512 + ks * 4096 + half * 2048; }
__device__ __forceinline__ int crow(int r, int hi) { return (r & 3) + 8 * (r >> 2) + 4 * hi; }
__device__ __forceinline__ unsigned cvtpk(float lo, float hi) { unsigned r; asm volatile("v_cvt_pk_bf16_f32 %0, %1, %2" : "=v"(r) : "v"(lo), "v"(hi)); return r; }
__device__ __forceinline__ float xchg32(float v, bool upper) {
    auto r = __builtin_amdgcn_permlane32_swap(__float_as_uint(v), __float_as_uint(v), false, false);
    return __uint_as_float(upper ? r[0] : r[1]);
}
__device__ __forceinline__ void qkt(f32x16& p0, f32x16& p1, const char* kbuf, int r32, int hi, const bf16x8* qr) {
    p0 = f32x16{}; p1 = f32x16{};
    const char* kb[4];
#pragma unroll
    for (int dd = 0; dd < 4; ++dd) kb[dd] = kbuf + KSWZ(r32, (dd * 16 + hi * 8) * 2);
#pragma unroll
    for (int d0 = 0; d0 < 8; ++d0) { const char* a = kb[d0 & 3] + (d0 >> 2) * 128;
        bf16x8 b0 = *reinterpret_cast<const bf16x8*>(a);
        bf16x8 b1 = *reinterpret_cast<const bf16x8*>(a + 32 * 256);
        p0 = __builtin_amdgcn_mfma_f32_32x32x16_bf16(b0, qr[d0], p0, 0, 0, 0);
        p1 = __builtin_amdgcn_mfma_f32_32x32x16_bf16(b1, qr[d0], p1, 0, 0, 0); }
}
__device__ __forceinline__ void qkt1(f32x16& p, const char* kbuf, int half, int r32, int hi, const bf16x8* qr) {
    p = f32x16{};
    const char* kb[4];
#pragma unroll
    for (int dd = 0; dd < 4; ++dd) kb[dd] = kbuf + half * (32 * 256) + KSWZ(r32, (dd * 16 + hi * 8) * 2);
#pragma unroll
    for (int d0 = 0; d0 < 8; ++d0) { const bf16x8 b0 = *reinterpret_cast<const bf16x8*>(kb[d0 & 3] + (d0 >> 2) * 128);
        p = __builtin_amdgcn_mfma_f32_32x32x16_bf16(b0, qr[d0], p, 0, 0, 0); }
}
#define PK4(P, B_, OUT) do { unsigned a0 = cvtpk(P[B_+0], P[B_+1]), a1 = cvtpk(P[B_+2], P[B_+3]);                          \
        unsigned b0 = cvtpk(P[B_+4], P[B_+5]), b1 = cvtpk(P[B_+6], P[B_+7]);                                             \
        auto r0 = __builtin_amdgcn_permlane32_swap(a0, b0, false, false); auto r1 = __builtin_amdgcn_permlane32_swap(a1, b1, false, false); \
        u32x4 w = {r0[0], r1[0], r0[1], r1[1]}; OUT = *reinterpret_cast<bf16x8*>(&w); } while (0)
__device__ __forceinline__ void pack_h(const f32x16& p, bf16x8& pa, bf16x8& pb) { PK4(p, 0, pa); PK4(p, 8, pb); }
#undef PK4
__device__ __forceinline__ void pv_tile(f32x16* o, int vb0, bf16x8 pa0, bf16x8 pa1, bf16x8 pa2, bf16x8 pa3) {
#define TRRD(dst, off) asm volatile("ds_read_b64_tr_b16 %0, %1 offset:%2" : "=&v"(dst) : "v"(vb0), "i"(off) : "memory")
#define PV_D0(d0) do { s16x4 l0, l1, l2, l3, h0, h1, h2, h3; constexpr int b_ = v_rd_off(d0, 0, 0); \
        TRRD(l0, b_); TRRD(h0, b_ + 2048); TRRD(l1, b_ + 4096); TRRD(h1, b_ + 6144); TRRD(l2, b_ + 8192); TRRD(h2, b_ + 10240); TRRD(l3, b_ + 12288); TRRD(h3, b_ + 14336); \
        asm volatile("s_waitcnt lgkmcnt(0)" ::: "memory"); SBAR(); \
        o[d0] = __builtin_amdgcn_mfma_f32_32x32x16_bf16(pa0, (bf16x8){l0[0], l0[1], l0[2], l0[3], h0[0], h0[1], h0[2], h0[3]}, o[d0], 0, 0, 0);   \
        o[d0] = __builtin_amdgcn_mfma_f32_32x32x16_bf16(pa1, (bf16x8){l1[0], l1[1], l1[2], l1[3], h1[0], h1[1], h1[2], h1[3]}, o[d0], 0, 0, 0);   \
        o[d0] = __builtin_amdgcn_mfma_f32_32x32x16_bf16(pa2, (bf16x8){l2[0], l2[1], l2[2], l2[3], h2[0], h2[1], h2[2], h2[3]}, o[d0], 0, 0, 0);   \
        o[d0] = __builtin_amdgcn_mfma_f32_32x32x16_bf16(pa3, (bf16x8){l3[0], l3[1], l3[2], l3[3], h3[0], h3[1], h3[2], h3[3]}, o[d0], 0, 0, 0); } while (0)
    PV_D0(0); PV_D0(1); PV_D0(2); PV_D0(3);
#undef PV_D0
#undef TRRD
}
__device__ __forceinline__ void pack_p(const f32x16& p0, const f32x16& p1, bf16x8& pa0, bf16x8& pa1, bf16x8& pa2, bf16x8& pa3) {
#define PK4(P, B_, OUT) do { unsigned a0 = cvtpk(P[B_+0], P[B_+1]), a1 = cvtpk(P[B_+2], P[B_+3]);                          \
        unsigned b0 = cvtpk(P[B_+4], P[B_+5]), b1 = cvtpk(P[B_+6], P[B_+7]);                                             \
        auto r0 = __builtin_amdgcn_permlane32_swap(a0, b0, false, false); auto r1 = __builtin_amdgcn_permlane32_swap(a1, b1, false, false); \
        u32x4 w = {r0[0], r1[0], r0[1], r1[1]}; OUT = *reinterpret_cast<bf16x8*>(&w); } while (0)
    PK4(p0, 0, pa0); PK4(p0, 8, pa1); PK4(p1, 0, pa2); PK4(p1, 8, pa3);
#undef PK4
}
template <bool MASK>
__device__ __forceinline__ void sb_half(f32x16& P, float& R, int dq  , int hi) {
    float suf[16], T[4];
#pragma unroll
    for (int g = 0; g < 4; ++g) {
        float run = 0.f;
#pragma unroll
        for (int e = 3; e >= 0; --e) { const int r = 4 * g + e; const float z = P[r]; const float sp = __builtin_amdgcn_logf(1.0f + __builtin_amdgcn_exp2f(-fabsf(z)));
            float l = -(fmaxf(z, 0.f) + sp);
            if (MASK) { const int c = e + 8 * g; if (!(c < dq)) l = 0.f; }
            run += l; suf[r] = run; }
        T[g] = run;
    }
    float Tp[4], E[4];
#pragma unroll
    for (int g = 0; g < 4; ++g) Tp[g] = xchg32(T[g], hi != 0);
    E[3] = R; E[2] = E[3] + (T[3] + Tp[3]); E[1] = E[2] + (T[2] + Tp[2]); E[0] = E[1] + (T[1] + Tp[1]); R = E[0] + (T[0] + Tp[0]);
#pragma unroll
    for (int g = 0; g < 4; ++g) { const float off = E[g] + (hi == 0 ? Tp[g] : 0.f);
#pragma unroll
        for (int e = 0; e < 4; ++e) { const int r = 4 * g + e; float a = __builtin_amdgcn_exp2f(P[r] + (off + suf[r]));
            if (MASK) { const int c = e + 8 * g; if (!(c < dq)) a = 0.f; }
            P[r] = a; } }
}

template <int GROUP>
__device__ __forceinline__ void attn_unit(int qb, const bf16* Qh, const bf16* Kh, const bf16* Vh, const float* km  , bf16* O, float* ssq, char* lds) {
    int tid_ = threadIdx.x; asm volatile("" : "+v"(tid_));
    const int tid = tid_, wid = __builtin_amdgcn_readfirstlane(tid >> 6), lane = tid & 63, r32 = lane & 31, hi = lane >> 5;
    char* V_lds = lds + A_V; char* K_lds = lds + A_K; float* wsf = (float*)(lds + A_WS) + wid * 64; float* kms = (float*)(lds + A_KM);
    const int q0 = qb * QB, qlo = q0 + wid * QBLK, qpos = qlo + r32;
    const int NT = (q0 + QB) / KVBLK;
    const int sr = tid >> 4, sc = (tid & 15) * 8, vst0 = v_st(sr, sc), vst1 = v_st(32 + sr, sc), kws = KSWZ(sr, sc * 2);
    const int vrb = (int)(uintptr_t)V_lds + v_rd_base(lane);
    bf16x8 qr[8];
#pragma unroll
    for (int d0 = 0; d0 < 8; ++d0) qr[d0] = *reinterpret_cast<const bf16x8*>(Qh + (size_t)(qlo + r32) * D + d0 * 16 + hi * 8);
    bf16x8 st_k0, st_k1, st_v0, st_v1;
#define TILE_OF(step) (GROUP == 0 ? (step) : (NT - 1 - (step)))
#define SLOAD(step) do { const size_t k0_ = (size_t)TILE_OF(step) * KVBLK; \
        st_k0 = *reinterpret_cast<const bf16x8*>(Kh + (k0_ + sr) * D + sc); st_k1 = *reinterpret_cast<const bf16x8*>(Kh + (k0_ + 32 + sr) * D + sc); \
        st_v0 = *reinterpret_cast<const bf16x8*>(Vh + (k0_ + sr) * D + sc); st_v1 = *reinterpret_cast<const bf16x8*>(Vh + (k0_ + 32 + sr) * D + sc); } while (0)
#define SWRITE(bf) do { *(bf16x8*)(K_lds + (bf) * SHM_K + kws) = st_k0; *(bf16x8*)(K_lds + (bf) * SHM_K + kws + 32 * 256) = st_k1; \
        *(bf16x8*)(V_lds + (bf) * SHM_V + vst0) = st_v0; *(bf16x8*)(V_lds + (bf) * SHM_V + vst1) = st_v1; } while (0)
    SLOAD(0);
    unsigned sel = 0xffu;
    if (GROUP == 0) {
        kms[tid] = km[tid]; kms[tid + 512] = km[tid + 512];
        __syncthreads();
        float gate[8];
#pragma unroll
        for (int j = 0; j < 8; ++j) { float s = 0.f;
#pragma unroll
            for (int d0 = 0; d0 < 8; ++d0) { const f32x4 ka = *(const f32x4*)(kms + j * 128 + d0 * 16 + hi * 8), kb = *(const f32x4*)(kms + j * 128 + d0 * 16 + hi * 8 + 4);
#pragma unroll
                for (int e = 0; e < 4; ++e) { s += __uint_as_float((unsigned)(unsigned short)qr[d0][e] << 16) * ka[e]; s += __uint_as_float((unsigned)(unsigned short)qr[d0][e + 4] << 16) * kb[e]; } }
            gate[j] = s + xchg32(s, hi != 0); }
        sel = 0u;
#pragma unroll
        for (int j = 0; j < 8; ++j) { int rank = 0;
#pragma unroll
            for (int jj = 0; jj < 8; ++jj) if (jj < qb && (gate[jj] > gate[j] || (gate[jj] == gate[j] && jj < j))) ++rank;
            if (j < qb && rank < 3) sel |= 1u << j; }
    }
    float m_reg = -1e30f, l_reg = 0.f, R = 0.f; f32x16 o[4];
    { float zz = 0.f; asm volatile("" : "+v"(zz));
#pragma unroll
      for (int d_ = 0; d_ < 4; ++d_)
#pragma unroll
          for (int r = 0; r < 16; ++r) o[d_][r] = zz; }
    asm volatile("s_waitcnt vmcnt(0)" ::: "memory"); SWRITE(0);
    __syncthreads();
    for (int step = 0; step < NT; ++step) {
        const int t = TILE_OF(step), kb = t * KVBLK, bf = step & 1;
        if (step + 1 < NT) SLOAD(step + 1);
        const bool act = (GROUP == 0) ? (kb <= qlo + QBLK - 1) : (kb <= qlo);
        if (act) {
            f32x16 p0, p1; bf16x8 pa0, pa1, pa2, pa3;
            if (GROUP == 0) {
                qkt(p0, p1, K_lds + bf * SHM_K, r32, hi, qr);
                const float NEG = -__builtin_inff();
                if (kb < q0) { if (!((sel >> (t >> 2)) & 1u)) {
#pragma unroll
                        for (int r = 0; r < 16; ++r) { p0[r] = NEG; p1[r] = NEG; } } }
                else if (kb + KVBLK - 1 > qlo) { const int dq = qpos - kb - 4 * hi;
#pragma unroll
                    for (int r = 0; r < 16; ++r) { const int c = (r & 3) + 8 * (r >> 2); if (c > dq) p0[r] = NEG; if (c + 32 > dq) p1[r] = NEG; } }
                float pmax = p0[0];
#pragma unroll
                for (int r = 1; r < 16; ++r) pmax = fmaxf(pmax, p0[r]);
#pragma unroll
                for (int r = 0; r < 16; ++r) pmax = fmaxf(pmax, p1[r]);
                pmax = fmaxf(pmax, xchg32(pmax, hi != 0));
                float alpha = 1.f, mn = m_reg;
                if (!__all(pmax - m_reg <= 11.5f)) { mn = fmaxf(m_reg, pmax); alpha = __builtin_amdgcn_exp2f(m_reg - mn); m_reg = mn; }
                float ps = 0.f;
#pragma unroll
                for (int r = 0; r < 16; ++r) { p0[r] = __builtin_amdgcn_exp2f(p0[r] - mn); p1[r] = __builtin_amdgcn_exp2f(p1[r] - mn); ps += p0[r] + p1[r]; }
                ps += xchg32(ps, hi != 0);
                l_reg = l_reg * alpha + ps;
                if (__any(alpha < 1.f)) { if (hi == 0) wsf[r32] = alpha; asm volatile("s_waitcnt lgkmcnt(0)" ::: "memory");
#pragma unroll
                    for (int d_ = 0; d_ < 4; ++d_)
#pragma unroll
                        for (int r = 0; r < 16; ++r) o[d_][r] *= wsf[crow(r, hi)]; }
                pack_p(p0, p1, pa0, pa1, pa2, pa3);
            } else {
                const int dq = qpos - kb - 4 * hi; const bool msk = kb + KVBLK - 1 >= qlo;
                qkt1(p1, K_lds + bf * SHM_K, 1, r32, hi, qr);
                if (msk) sb_half<true>(p1, R, dq - 32, hi); else sb_half<false>(p1, R, 0, hi);
                pack_h(p1, pa2, pa3); SBAR();
                qkt1(p0, K_lds + bf * SHM_K, 0, r32, hi, qr);
                if (msk) sb_half<true>(p0, R, dq, hi); else sb_half<false>(p0, R, 0, hi);
                pack_h(p0, pa0, pa1);
            }
            pv_tile(o, vrb + bf * SHM_V, pa0, pa1, pa2, pa3);
        }
        if (step + 1 < NT) { asm volatile("s_waitcnt vmcnt(0)" ::: "memory"); SWRITE(bf ^ 1); }
        __syncthreads();
    }
    if (GROUP == 0) { if (hi == 0) wsf[32 + r32] = l_reg; asm volatile("s_waitcnt lgkmcnt(0)" ::: "memory"); }
    int hi_e = hi, c_e = r32; asm volatile("" : "+v"(hi_e), "+v"(c_e));
    bf16* Ow = O + (size_t)(qlo + 4 * hi_e) * DM + c_e; float* sq = ssq + qlo + 4 * hi_e;
#pragma unroll
    for (int r = 0; r < 16; ++r) { const int orow = crow(r, hi), or0 = (r & 3) + 8 * (r >> 2); const float rl = (GROUP == 0) ? __builtin_amdgcn_rcpf(wsf[32 + orow]) : 1.f; float ss = 0.f;
#pragma unroll
        for (int d0 = 0; d0 < 4; ++d0) { const float v = o[d0][r] * rl; ss += v * v; const float vn = __shfl_xor(v, 1);
            if ((r32 & 1) == 0) *(unsigned*)(Ow + (size_t)or0 * DM + d0 * 32) = cvtpk(v, vn); }
        ss += __shfl_xor(ss, 1); ss += __shfl_xor(ss, 2); ss += __shfl_xor(ss, 4); ss += __shfl_xor(ss, 8); ss += __shfl_xor(ss, 16);
        if (r32 == 0) sq[or0] = ss; }
    __syncthreads();
#undef TILE_OF
#undef SLOAD
#undef SWRITE
}
#undef KSWZ
#undef SBAR
}

__device__ __forceinline__ void attn_phase(Frame& F, const bf16* QKV, const float* kmean, bf16* OB, float* ssqa, float* ssqb) {
    char* lds = (char*)F.lds + RING_OFF;
    const size_t TS = (size_t)M * DG;
    for (int v = F.vcu; v < 256; v += F.G) {
        const int bh = v >> 3, i = v & 7, b = bh >> 3, h = bh & 7;
        const size_t ho = (size_t)bh * SEQ * HD;
#if !NAIVE_MOBA
        att::attn_unit<0>(i, QKV + ho, QKV + TS + ho, QKV + 2 * TS + ho, kmean + (size_t)bh * 8 * HD, OB + (size_t)b * SEQ * DM + h * HD, ssqa + (size_t)h * M + b * SEQ, lds);
#endif
#if !NAIVE_SB
        att::attn_unit<1>(7 - i, QKV + 3 * TS + ho, QKV + 4 * TS + ho, QKV + 5 * TS + ho, nullptr, OB + (size_t)b * SEQ * DM + DG + h * HD, ssqb + (size_t)h * M + b * SEQ, lds);
#endif
    }
}


__global__ void __launch_bounds__(NWAVES * 64, 2) fwd_megakernel(Args args) {
    extern __shared__ __attribute__((aligned(16))) unsigned char lds[];
    Frame F;
    F.lds = (LAS unsigned char*)lds;
    F.MISC = (volatile LAS unsigned*)(F.lds + MISC_OFF);
    F.G = gridDim.x; { const int bx = blockIdx.x; F.vcu = (F.G % 8 == 0) ? (bx % 8) * (F.G / 8) + bx / 8 : bx; }
    unsigned char* ws = args.ws;
    F.ctl = (gu32*)(ws + WS_CTL);
    const float* x = args.in[0]; const float* mix_g = args.in[1]; const float* w_in = args.in[2]; const float* moba_g = args.in[3]; const float* sb_g = args.in[4];
    const float* w_out = args.in[5]; const float* mlp_g = args.in[6]; const float* w_up = args.in[7]; const float* w_down = args.in[8]; const float* fin_g = args.in[9];
    float* out = args.out;
    bf16* Win_t = (bf16*)(ws + WS_WIN); bf16* Wout_t = (bf16*)(ws + WS_WOUT); bf16* Wup_t = (bf16*)(ws + WS_WUP); bf16* Wdown_t = (bf16*)(ws + WS_WDOWN);
    bf16* XB = (bf16*)out; bf16* X1B = (bf16*)(ws + WS_X1B); bf16* QKV = (bf16*)(ws + WS_QKV); bf16* OB = (bf16*)(ws + WS_O); bf16* ACT = (bf16*)(ws + WS_ACT);
    float* kmean = (float*)(ws + WS_KMEAN); float* r0 = (float*)(ws + WS_R0); float* rope = (float*)(ws + WS_ROPE);
    float* ssqa = (float*)(ws + WS_SSQA); float* ssqb = (float*)(ws + WS_SSQB); float* ssq1 = (float*)(ws + WS_SSQ1); float* ssq2 = (float*)(ws + WS_SSQ2);
    for (int u = threadIdx.x; u < (LDS_BYTES - LDSCTL_OFF) / 4; u += NWAVES * 64) ((LAS unsigned*)(F.lds + LDSCTL_OFF))[u] = 0u;
    __syncthreads();
    XcdBarrier bar; bar.bar = (unsigned*)(F.ctl + CW_BAR); bar.x = 0; bar.st = nullptr;
    if (MK_MODE == 0) bar = xcd_barrier_post((unsigned*)(F.ctl + CW_BAR), F.MISC + 8);
#define GRID_BAR() do { if (MK_MODE == 0) xcd_barrier(bar); } while (0)
    const int lo = args.ph_lo, hi = args.ph_hi;
#define IN(k) (lo <= (k) && (k) < hi)
#define BOTH(k) (IN(k) && IN((k) + 1))
    const int NGW = F.G * NWAVES;
#define PH_IDS() int tid_ = threadIdx.x; asm volatile("" : "+v"(tid_)); const int tid = tid_, lane = tid & 63, wave = __builtin_amdgcn_readfirstlane(tid >> 6), gw = F.vcu * NWAVES + wave; (void)lane; (void)gw

    if (IN(0)) REPS(0) {
        PH_IDS();
        constexpr int T_IN = (DM / 64) * (DQKV / 256), T_OUT = (DM / 64) * (DM / 256), T_UP = (DM / 64) * (DFF / 256), T_DN = (DFF / 64) * (DM / 256), NT0 = T_IN + T_OUT + T_UP + T_DN;
        static_assert(NT0 % 256 == 0 && (NT0 / 256) % 3 == 0, "P0 tiles divide over 256 workgroups in threes");
        const int per = NT0 / F.G;
#define P0_TILE(T_) const float* W_; const float* g_; bf16* WT_; int K_, N_, k0_, n0_; { int r_ = (T_); \
            if (r_ < T_IN) { W_ = w_in; g_ = mix_g; WT_ = Win_t; K_ = DM; N_ = DQKV; } \
            else if ((r_ -= T_IN) < T_OUT) { W_ = w_out; g_ = (r_ / (DM / 256)) * 64 < DG ? moba_g : (sb_g - DG); WT_ = Wout_t; K_ = DM; N_ = DM; } \
            else if ((r_ -= T_OUT) < T_UP) { W_ = w_up; g_ = mlp_g; WT_ = Wup_t; K_ = DM; N_ = DFF; } \
            else { r_ -= T_UP; W_ = w_down; g_ = nullptr; WT_ = Wdown_t; K_ = DFF; N_ = DM; } \
            const int nb_ = N_ / 256; k0_ = (r_ / nb_) * 64; n0_ = (r_ % nb_) * 256; }
#define P0_LOAD(S_, it_) do { P0_TILE(F.vcu + (it_) * F.G); (void)g_; (void)WT_; (void)K_; const float* p_ = W_ + (size_t)(k0_ + 8 * wave) * N_ + n0_ + 4 * lane; \
            _Pragma("unroll") for (int i = 0; i < 8; ++i) S_[i] = *(const GAS f32x4*)(p_ + (size_t)i * N_); } while (0)
#define P0_PROC(S_, it_) do { P0_TILE(F.vcu + (it_) * F.G); (void)W_; LAS unsigned char* tb_ = F.lds + RING_OFF + ((it_) & 1) * 32768; \
            float gg_[8]; _Pragma("unroll") for (int i = 0; i < 8; ++i) gg_[i] = g_ ? g_[k0_ + 8 * wave + i] : 1.f; \
            _Pragma("unroll") for (int j = 0; j < 4; ++j) { v4u o_; o_.x = pg8::cvt_pk_bf16(S_[0][j] * gg_[0], S_[1][j] * gg_[1]); o_.y = pg8::cvt_pk_bf16(S_[2][j] * gg_[2], S_[3][j] * gg_[3]); \
                o_.z = pg8::cvt_pk_bf16(S_[4][j] * gg_[4], S_[5][j] * gg_[5]); o_.w = pg8::cvt_pk_bf16(S_[6][j] * gg_[6], S_[7][j] * gg_[7]); \
                *(LAS v4u*)(tb_ + (4 * lane + j) * 128 + ((wave ^ (lane & 7)) * 16)) = o_; } \
            __syncthreads(); \
            _Pragma("unroll") for (int q = 0; q < 4; ++q) { const int cid_ = tid + 512 * q, nl_ = cid_ >> 3, c_ = cid_ & 7; \
                const v4u o_ = *(const LAS v4u*)(tb_ + nl_ * 128 + ((c_ ^ ((nl_ >> 2) & 7)) * 16)); \
                *(GAS v4u*)(WT_ + (size_t)(n0_ + nl_) * K_ + k0_ + 8 * c_) = o_; } } while (0)
        if (F.G == 256) {
            f32x4 sA[8], sB[8], sC[8];
            P0_LOAD(sA, 0); P0_LOAD(sB, 1);
            for (int it = 0; it < per; it += 3) {
                P0_LOAD(sC, it + 2); P0_PROC(sA, it);
                if (it + 3 < per) P0_LOAD(sA, it + 3);
                P0_PROC(sB, it + 1);
                if (it + 4 < per) P0_LOAD(sB, it + 4);
                P0_PROC(sC, it + 2);
            }
        }
#undef P0_TILE
#undef P0_LOAD
#undef P0_PROC
        for (int m = gw * 2; m < M; m += NGW * 2) {
            const GAS f32x4* xr = (const GAS f32x4*)(x + (size_t)m * DM) + lane; f32x4 v[16]; float s0 = 0.f, s1 = 0.f;
#pragma unroll
            for (int j = 0; j < 16; ++j) v[j] = xr[64 * j];
#pragma unroll
            for (int j = 0; j < 8; ++j) { s0 += (v[j].x * v[j].x + v[j].y * v[j].y) + (v[j].z * v[j].z + v[j].w * v[j].w); s1 += (v[j + 8].x * v[j + 8].x + v[j + 8].y * v[j + 8].y) + (v[j + 8].z * v[j + 8].z + v[j + 8].w * v[j + 8].w); }
            s0 = wave_sum(s0); s1 = wave_sum(s1);
            if (lane == 0) { r0[m] = 1.0f / sqrtf(s0 * (1.0f / DM) + EPS); r0[m + 1] = 1.0f / sqrtf(s1 * (1.0f / DM) + EPS); }
            GAS unsigned long long* o8 = (GAS unsigned long long*)(XB + (size_t)m * DM) + lane;
#pragma unroll
            for (int j = 0; j < 16; ++j) o8[64 * j] = (unsigned long long)pg8::cvt_pk_bf16(v[j].x, v[j].y) | ((unsigned long long)pg8::cvt_pk_bf16(v[j].z, v[j].w) << 32);
        }
        for (int e = blockIdx.x * (NWAVES * 64) + tid; e < SEQ * 16; e += F.G * NWAVES * 64) {
            const int pos = e >> 4, j = e & 15;
            const float inv = powf(500000.0f, -(float)j / 16.0f); const float ang = (float)pos * inv;
            const double tw = 6.283185307179586476925; const double a = (double)ang; const double red = a - tw * rint(a / tw); const float rf = (float)red;
            rope[pos * 32 + j] = cosf(rf); rope[pos * 32 + 16 + j] = sinf(rf);
        }
        if (BOTH(0)) GRID_BAR();
    }

    if (IN(1)) REPS(1) {
        pg8::Gemm g{XB, Win_t, M, DQKV, DM}; pg8::StaticOrder S; S.init(M, DQKV, F.G, (int)blockIdx.x);
        pg8::EpiQKV E{QKV, r0, rope, rep_ == 0 ? kmean : nullptr};
        pg8::gemm_phase<pg8::EpiQKV, pg8::StaticOrder, true, true>(F.lds + RING_OFF, g, S, E);
        if (BOTH(1)) GRID_BAR();
    }

    if (IN(2)) REPS(2) {
        attn_phase(F, QKV, kmean, OB, ssqa, ssqb);
        if (BOTH(2)) GRID_BAR();
    }

    if (IN(3)) REPS(3) {
        pg8::Gemm g{OB, Wout_t, M, DM, DM}; pg8::StaticOrder S; S.init(M, DM, F.G, (int)blockIdx.x);
        LAS float* tab = (LAS float*)(F.lds + TAB_OFF); LAS float* P = (LAS float*)(F.lds + PST_OFF);
        pg8::Unit u0; PH_IDS();
        if (S.next(0, u0) && tid < 256) { const int row = u0.pm * 256 + tid; float sa = 0.f, sb = 0.f;
#pragma unroll
            for (int h = 0; h < 8; ++h) { sa += ssqa[(size_t)h * M + row]; sb += ssqb[(size_t)h * M + row]; }
            const float ra = 1.0f / sqrtf(sa * (1.0f / DG) + EPS), rb = 1.0f / sqrtf(sb * (1.0f / DG) + EPS);
            tab[tid * 2] = ra / rb; tab[tid * 2 + 1] = rb; }
        __syncthreads();
        pg8::EpiOut E{x, out, X1B, ssq1, tab, P};
        pg8::gemm_phase<pg8::EpiOut, pg8::StaticOrder, false, true>(F.lds + RING_OFF, g, S, E);
        if (BOTH(3)) GRID_BAR();
    }

    if (IN(4)) REPS(4) {
        pg8::Gemm g{X1B, Wup_t, M, DFF, DM}; pg8::StaticOrder S; S.init(M, DFF, F.G, (int)blockIdx.x);
        pg8::EpiUp E{ACT, ssq1};
        pg8::gemm_phase<pg8::EpiUp, pg8::StaticOrder, true, true>(F.lds + RING_OFF, g, S, E);
        if (BOTH(4)) GRID_BAR();
    }

    if (IN(5)) {
        pg8::Gemm g{ACT, Wdown_t, M, DM, DFF}; pg8::StaticOrder S; S.init(M, DM, F.G, (int)blockIdx.x);
        LAS float* P = (LAS float*)(F.lds + PST_OFF);
        pg8::EpiDown E{out, ssq2, P};
        pg8::gemm_phase<pg8::EpiDown, pg8::StaticOrder, false, true>(F.lds + RING_OFF, g, S, E);
        if (BOTH(5)) GRID_BAR();
    }

    if (IN(6)) {
        PH_IDS();
        for (int m = gw; m < M; m += NGW) {
            float sq = 0.f;
#pragma unroll
            for (int p = 0; p < 8; ++p) sq += ssq2[(size_t)p * M + m];
            const float r = 1.0f / sqrtf(sq * (1.0f / DM) + EPS);
            GAS f32x4* xr = (GAS f32x4*)(out + (size_t)m * DM) + lane; const GAS f32x4* gr = (const GAS f32x4*)fin_g + lane;
#pragma unroll
            for (int j = 0; j < 8; ++j) { const f32x4 v = xr[64 * j]; const f32x4 gg = gr[64 * j]; xr[64 * j] = v * r * gg; }
        }
    }
#undef IN
#undef BOTH
}

extern "C" void kernel_launch(void* const* d_in, const int* in_sizes, int n_in, void* d_out, int out_size, void* d_ws, size_t ws_size, hipStream_t stream) {
    static int grid = 0;
    if (grid == 0) {
        if (n_in != 10 || in_sizes[0] != M * DM || out_size != M * DM || ws_size < WS_END) { fprintf(stderr, "kernel_launch: shape/workspace mismatch (n_in %d, in0 %d, out %d, ws %zu)\n", n_in, n_in > 0 ? in_sizes[0] : -1, out_size, ws_size); grid = -1; return; }
        int dev = 0, cus = 0, per_cu = 0;
        if (hipGetDevice(&dev) != hipSuccess || hipDeviceGetAttribute(&cus, hipDeviceAttributeMultiprocessorCount, dev) != hipSuccess) { fprintf(stderr, "kernel_launch: device query failed\n"); grid = -1; return; }
        if (hipFuncSetAttribute((const void*)fwd_megakernel, hipFuncAttributeMaxDynamicSharedMemorySize, LDS_BYTES) != hipSuccess) { fprintf(stderr, "kernel_launch: hipFuncSetAttribute failed\n"); grid = -1; return; }
        if (hipOccupancyMaxActiveBlocksPerMultiprocessor(&per_cu, (const void*)fwd_megakernel, NWAVES * 64, LDS_BYTES) != hipSuccess || per_cu < 1) { fprintf(stderr, "kernel_launch: occupancy query reports %d blocks per CU\n", per_cu); }
        (void)hipGetLastError();
        grid = cus;
        if (grid != 256) fprintf(stderr, "kernel_launch: %d CUs (built for 256)\n", grid);
    }
    if (grid < 0) return;
    (void)hipMemsetAsync((char*)d_ws + WS_CTL, 0, CTL_ZERO_BYTES, stream);
    Args a{};
    for (int i = 0; i < 10; ++i) a.in[i] = (const float*)d_in[i];
    a.out = (float*)d_out; a.ws = (unsigned char*)d_ws;
#if MK_MODE == 0
    a.ph_lo = 0; a.ph_hi = N_PHASES; a.li = 0;
    hipLaunchKernelGGL(fwd_megakernel, dim3(grid), dim3(NWAVES * 64), LDS_BYTES, stream, a);
#else
    unsigned char* ws = (unsigned char*)d_ws;
    for (int p = 0; p < N_PHASES; ++p) {
        a.ph_lo = p; a.ph_hi = p + 1; a.li = p;
        hipLaunchKernelGGL(fwd_megakernel, dim3(grid), dim3(NWAVES * 64), LDS_BYTES, stream, a);
        if (p == 2) {
            const bf16* QKV = (const bf16*)(ws + WS_QKV); const size_t TS = (size_t)M * DG;
            if (NAIVE_MOBA) hipLaunchKernelGGL(naive_moba, dim3(BATCH * NH * SEQ / 4), dim3(256), 0, stream, QKV, QKV + TS, QKV + 2 * TS, (const float*)(ws + WS_KMEAN), (bf16*)(ws + WS_O), (float*)(ws + WS_SSQA));
            if (NAIVE_SB) hipLaunchKernelGGL(naive_sb, dim3(BATCH * NH * SEQ / 4), dim3(256), 0, stream, QKV + 3 * TS, QKV + 4 * TS, QKV + 5 * TS, (bf16*)(ws + WS_O), (float*)(ws + WS_SSQB));
        }
    }
#endif
}
```
